# Optimizing an MI355X kernel written in HIP

```python
import jax, jax.numpy as jnp
from jax import lax
import numpy as np

D_MODEL = 1024
BATCH = 4
SEQ = 8192
DEPTH = 1
DEC_BATCH = 128
DEC_SEQ = 8
PAST_LEN = 8192
PAGE_SIZE = 128

HEAD_DIM = 64
HEADS_PER_GROUP = D_MODEL // 128
ATTN_GROUPS = ((128, 1), (512, 4), (2048, 16))
N_GROUPS = 3
ATTN_HEADS = N_GROUPS * HEADS_PER_GROUP
ATTN_QKV_WIDTH = ATTN_HEADS * HEAD_DIM
ATTN_WIDTH = HEADS_PER_GROUP * HEAD_DIM
ROPE_DIM = HEAD_DIM // 4
ROPE_THETA = 500000.0
BAND_BLOCK = 128

GLA_HEADS = 4
GLA_DK = D_MODEL // 16
GLA_DV = D_MODEL // 8
GLA_KEY_WIDTH = GLA_HEADS * GLA_DK
GLA_VAL_WIDTH = GLA_HEADS * GLA_DV
GLA_GATE_RANK = 16
GLA_TAU = 16.0
GLA_CHUNK = 64

NORM_EPS = 1e-6
IN_WIDTH = 3 * ATTN_QKV_WIDTH + ATTN_WIDTH + 2 * GLA_KEY_WIDTH + 2 * GLA_VAL_WIDTH + GLA_GATE_RANK + 2 * D_MODEL

kernel_name = "dilated_window_gla_hybrid_step"


def rms_norm(x, w):
    xf = x.astype(jnp.float32)
    y = xf * lax.rsqrt(jnp.mean(xf * xf, axis=-1, keepdims=True) + NORM_EPS)
    return (y * w.astype(jnp.float32)).astype(x.dtype)


def partial_rope(x, pos):
    half = ROPE_DIM // 2
    inv_freq = 1.0 / (ROPE_THETA ** (jnp.arange(half, dtype=jnp.float32) * (2.0 / ROPE_DIM)))
    ang = pos.astype(jnp.float32)[:, None] * inv_freq[None, :]
    cos = jnp.cos(ang)[:, None, :]
    sin = jnp.sin(ang)[:, None, :]
    xr = x[..., :ROPE_DIM].astype(jnp.float32)
    x1, x2 = xr[..., :half], xr[..., half:]
    rot = jnp.concatenate([x1 * cos - x2 * sin, x2 * cos + x1 * sin], axis=-1)
    return jnp.concatenate([rot.astype(x.dtype), x[..., ROPE_DIM:]], axis=-1)


def project_in(x, pos, ln_w, w_in, w_gla_a2, b_gla_a):
    B, S, _ = x.shape
    h = rms_norm(x, ln_w)
    proj = jnp.einsum('bsd,de->bse', h, w_in)
    widths = (ATTN_QKV_WIDTH, ATTN_QKV_WIDTH, ATTN_QKV_WIDTH, ATTN_WIDTH,
              GLA_KEY_WIDTH, GLA_KEY_WIDTH, GLA_VAL_WIDTH, GLA_VAL_WIDTH, GLA_GATE_RANK,
              D_MODEL, D_MODEL)
    splits = [int(c) for c in np.cumsum(widths)[:-1]]
    aq, ak, av, az, gq, gk, gv, gz, glr, mg_a, mg_b = jnp.split(proj, splits, axis=-1)
    aq = partial_rope(aq.reshape(B, S, ATTN_HEADS, HEAD_DIM), pos) * (HEAD_DIM ** -0.5)
    ak = partial_rope(ak.reshape(B, S, ATTN_HEADS, HEAD_DIM), pos)
    av = av.reshape(B, S, ATTN_HEADS, HEAD_DIM)
    gq = gq.reshape(B, S, GLA_HEADS, GLA_DK).astype(jnp.float32) * (GLA_DK ** -0.5)
    gk = gk.reshape(B, S, GLA_HEADS, GLA_DK).astype(jnp.float32)
    gv = gv.reshape(B, S, GLA_HEADS, GLA_DV).astype(jnp.float32)
    gate_pre = (jnp.einsum('bsr,rk->bsk', glr, w_gla_a2) + b_gla_a).astype(jnp.float32)
    log_a = (jax.nn.log_sigmoid(gate_pre) / GLA_TAU).reshape(B, S, GLA_HEADS, GLA_DK)
    return aq, ak, av, az, gq, gk, gv, log_a, gz, mg_a, mg_b


def dilated_window_attn_prompt(q, k, v, window, dilation):
    B, S, H, dh = q.shape
    L = S // dilation
    reach = window // dilation
    blk = BAND_BLOCK
    nblk = -(-L // blk)
    Lp = nblk * blk
    BD = B * dilation

    def to_residue_blocks(t):
        t = t.reshape(B, L, dilation, H, dh).transpose(0, 2, 1, 3, 4).reshape(BD, L, H, dh)
        t = jnp.pad(t, ((0, 0), (0, Lp - L), (0, 0), (0, 0)))
        return t.reshape(BD, nblk, blk, H, dh)

    def with_prev_block(t):
        prev = jnp.pad(t, ((0, 0), (1, 0), (0, 0), (0, 0), (0, 0)))[:, :-1]
        return jnp.concatenate([prev, t], axis=2)

    qb = to_residue_blocks(q)
    kk = with_prev_block(to_residue_blocks(k))
    vv = with_prev_block(to_residue_blocks(v))
    s = jnp.einsum('bnqhd,bnkhd->bnhqk', qb, kk).astype(jnp.float32)
    qi = jnp.arange(blk)[:, None] + blk
    ki = jnp.arange(2 * blk)[None, :]
    dist = qi - ki
    band = (dist >= 0) & (dist <= reach)
    inside = (jnp.arange(nblk)[:, None, None] > 0) | (ki[None] >= blk)
    mask = band[None] & inside
    s = jnp.where(mask[None, :, None], s, -jnp.inf)
    m = jnp.max(s, axis=-1, keepdims=True)
    p = jnp.exp(s - m)
    den = jnp.sum(p, axis=-1, keepdims=True)
    o = jnp.einsum('bnhqk,bnkhd->bnqhd', p / den, vv.astype(jnp.float32))
    lse = (m + jnp.log(den))[..., 0]
    o = o.reshape(BD, Lp, H, dh)[:, :L]
    lse = lse.transpose(0, 1, 3, 2).reshape(BD, Lp, H)[:, :L]
    o = o.reshape(B, dilation, L, H, dh).transpose(0, 2, 1, 3, 4).reshape(B, S, H, dh)
    lse = lse.reshape(B, dilation, L, H).transpose(0, 2, 1, 3).reshape(B, S, H)
    return o, lse


def dilated_window_attn_sample(q, k, v, kv_buf, window, dilation):
    DB, T, H, dh = q.shape
    W_len = kv_buf.shape[1]
    k_all = jnp.concatenate([kv_buf[:, :, 0].astype(k.dtype), k], axis=1)
    v_all = jnp.concatenate([kv_buf[:, :, 1].astype(v.dtype), v], axis=1)
    reach = window // dilation
    idx = W_len + jnp.arange(T)[:, None] - dilation * jnp.arange(reach + 1)[None, :]
    valid = idx >= 0
    idx = jnp.maximum(idx, 0)
    kg = k_all[:, idx]
    vg = v_all[:, idx]
    s = jnp.einsum('bthd,btrhd->bthr', q, kg).astype(jnp.float32)
    s = jnp.where(valid[None, :, None, :], s, -jnp.inf)
    m = jnp.max(s, axis=-1, keepdims=True)
    p = jnp.exp(s - m)
    den = jnp.sum(p, axis=-1, keepdims=True)
    o = jnp.einsum('bthr,btrhd->bthd', p / den, vg.astype(jnp.float32))
    lse = (m + jnp.log(den))[..., 0]
    return o, lse


def combine_groups(outs, lses):
    o = jnp.stack(outs, axis=0)
    w = jax.nn.softmax(jnp.stack(lses, axis=0), axis=0)
    comb = jnp.einsum('gbsh,gbshd->bshd', w, o)
    B, S = comb.shape[0], comb.shape[1]
    return comb.reshape(B, S, ATTN_WIDTH)


def gla_recurrence(q, k, v, log_a, s0, chunk):
    B, S, H, dk = q.shape
    dv = v.shape[-1]
    nc = S // chunk

    def to_chunks(t):
        return t.reshape(B, nc, chunk, H, t.shape[-1]).transpose(1, 0, 3, 2, 4)

    qc, kc, vc, gc = to_chunks(q), to_chunks(k), to_chunks(v), to_chunks(log_a)
    bc = jnp.cumsum(gc, axis=3)
    causal = jnp.tril(jnp.ones((chunk, chunk), dtype=bool))

    def step(state, inp):
        q_, k_, v_, b_ = inp
        b_last = b_[:, :, -1:, :]
        qe = q_ * jnp.exp(b_)
        ke = k_ * jnp.exp(-b_)
        att = jnp.where(causal, jnp.einsum('bhtk,bhsk->bhts', qe, ke), 0.0)
        o = jnp.einsum('bhts,bhsv->bhtv', att, v_) + jnp.einsum('bhtk,bhkv->bhtv', qe, state)
        kd = k_ * jnp.exp(b_last - b_)
        new_state = jnp.exp(b_last[:, :, 0, :, None]) * state + jnp.einsum('bhsk,bhsv->bhkv', kd, v_)
        return new_state, o

    s_fin, o = lax.scan(step, s0, (qc, kc, vc, bc))
    o = o.transpose(1, 0, 3, 2, 4).reshape(B, S, H, dv)
    return o, s_fin


def merge_out(x, o_attn, az, o_gla, gz, mg_a, mg_b, gla_norm_w, w_attn_out, w_gla_out, w_out):
    B, S, _ = x.shape
    o_gla = rms_norm(o_gla, gla_norm_w).reshape(B, S, GLA_VAL_WIDTH).astype(x.dtype)
    ya = jnp.einsum('bsc,cd->bsd', o_attn.astype(x.dtype) * jax.nn.silu(az), w_attn_out)
    yb = jnp.einsum('bsc,cd->bsd', o_gla * jax.nn.silu(gz), w_gla_out)
    mixed = jax.nn.sigmoid(mg_a) * ya + jax.nn.sigmoid(mg_b) * yb
    return x + jnp.einsum('bsd,de->bse', mixed, w_out)


def setup_inputs(seed: int = 0) -> dict:
    key = jax.random.key(seed)
    ks = jax.random.split(key, 16)
    f32 = jnp.float32
    w_lens = [min(w, PAST_LEN) for w, _ in ATTN_GROUPS]
    return {
        'x_prompt': jax.random.normal(ks[0], (BATCH, SEQ, D_MODEL), f32),
        'x_sample': jax.random.normal(ks[1], (DEC_BATCH, DEC_SEQ, D_MODEL), f32),
        'cache_kv_w128': jax.random.normal(ks[2], (DEPTH, DEC_BATCH, w_lens[0], 2, HEADS_PER_GROUP, HEAD_DIM), f32),
        'cache_kv_w512': jax.random.normal(ks[3], (DEPTH, DEC_BATCH, w_lens[1], 2, HEADS_PER_GROUP, HEAD_DIM), f32),
        'cache_kv_w2048': jax.random.normal(ks[4], (DEPTH, DEC_BATCH, w_lens[2], 2, HEADS_PER_GROUP, HEAD_DIM), f32),
        'state_gla': jax.random.normal(ks[5], (DEPTH, DEC_BATCH, GLA_HEADS, GLA_DK, GLA_DV), f32),
        'ln_w': 1.0 + 0.01 * jax.random.normal(ks[6], (DEPTH, D_MODEL), f32),
        'w_in': jax.random.normal(ks[7], (DEPTH, D_MODEL, IN_WIDTH), f32) * D_MODEL ** -0.5,
        'w_gla_a2': jax.random.normal(ks[8], (DEPTH, GLA_GATE_RANK, GLA_KEY_WIDTH), f32) * GLA_GATE_RANK ** -0.5,
        'b_gla_a': 0.1 * jax.random.normal(ks[9], (DEPTH, GLA_KEY_WIDTH), f32),
        'gla_norm_w': 1.0 + 0.01 * jax.random.normal(ks[10], (DEPTH, GLA_DV), f32),
        'w_attn_out': jax.random.normal(ks[11], (DEPTH, ATTN_WIDTH, D_MODEL), f32) * ATTN_WIDTH ** -0.5,
        'w_gla_out': jax.random.normal(ks[12], (DEPTH, GLA_VAL_WIDTH, D_MODEL), f32) * GLA_VAL_WIDTH ** -0.5,
        'w_out': jax.random.normal(ks[13], (DEPTH, D_MODEL, D_MODEL), f32) * D_MODEL ** -0.5,
        'final_norm_w': 1.0 + 0.01 * jax.random.normal(ks[14], (D_MODEL,), f32),
    }


def reference(x_prompt, x_sample, cache_kv_w128, cache_kv_w512, cache_kv_w2048, state_gla,
              ln_w, w_in, w_gla_a2, b_gla_a, gla_norm_w, w_attn_out, w_gla_out, w_out, final_norm_w):
    B, S, _ = x_prompt.shape
    DB, T, _ = x_sample.shape
    pos_p = jnp.arange(S, dtype=jnp.int32)
    pos_s = PAST_LEN + jnp.arange(T, dtype=jnp.int32)
    caches = (cache_kv_w128, cache_kv_w512, cache_kv_w2048)
    hp, hs = x_prompt, x_sample
    kv_p = [[] for _ in range(N_GROUPS)]
    kv_s = [[] for _ in range(N_GROUPS)]
    gla_p, gla_s = [], []
    for layer in range(DEPTH):
        aq, ak, av, az, gq, gk, gv, ga, gz, ma, mb = project_in(
            hp, pos_p, ln_w[layer], w_in[layer], w_gla_a2[layer], b_gla_a[layer])
        outs, lses = [], []
        for g, (win, dil) in enumerate(ATTN_GROUPS):
            hs_ = slice(g * HEADS_PER_GROUP, (g + 1) * HEADS_PER_GROUP)
            o, l = dilated_window_attn_prompt(aq[:, :, hs_], ak[:, :, hs_], av[:, :, hs_], win, dil)
            outs.append(o)
            lses.append(l)
            kv_p[g].append(jnp.stack([ak[:, :, hs_], av[:, :, hs_]], axis=2)[:, S - min(win, S):])
        o_attn = combine_groups(outs, lses)
        s0 = jnp.zeros((B, GLA_HEADS, GLA_DK, GLA_DV), jnp.float32)
        o_gla, s_fin = gla_recurrence(gq, gk, gv, ga, s0, min(GLA_CHUNK, S))
        gla_p.append(s_fin)
        hp = merge_out(hp, o_attn, az, o_gla, gz, ma, mb, gla_norm_w[layer],
                       w_attn_out[layer], w_gla_out[layer], w_out[layer])
        aq, ak, av, az, gq, gk, gv, ga, gz, ma, mb = project_in(
            hs, pos_s, ln_w[layer], w_in[layer], w_gla_a2[layer], b_gla_a[layer])
        outs, lses = [], []
        for g, (win, dil) in enumerate(ATTN_GROUPS):
            hs_ = slice(g * HEADS_PER_GROUP, (g + 1) * HEADS_PER_GROUP)
            o, l = dilated_window_attn_sample(aq[:, :, hs_], ak[:, :, hs_], av[:, :, hs_],
                                              caches[g][layer], win, dil)
            outs.append(o)
            lses.append(l)
            kv_s[g].append(jnp.stack([ak[:, :, hs_], av[:, :, hs_]], axis=2))
        o_attn = combine_groups(outs, lses)
        o_gla, s_new = gla_recurrence(gq, gk, gv, ga, state_gla[layer].astype(jnp.float32), T)
        gla_s.append(s_new)
        hs = merge_out(hs, o_attn, az, o_gla, gz, ma, mb, gla_norm_w[layer],
                       w_attn_out[layer], w_gla_out[layer], w_out[layer])
    y_prompt = rms_norm(hp, final_norm_w)
    y_sample = rms_norm(hs, final_norm_w)
    kv128_p, kv512_p, kv2048_p = (jnp.stack(kv_p[0]), jnp.stack(kv_p[1]), jnp.stack(kv_p[2]))
    kv128_s, kv512_s, kv2048_s = (jnp.stack(kv_s[0]), jnp.stack(kv_s[1]), jnp.stack(kv_s[2]))
    gla_prompt = jnp.stack(gla_p)
    gla_sample = jnp.stack(gla_s)
    return (y_prompt, y_sample, kv128_p, kv512_p, kv2048_p, gla_prompt, kv128_s, kv512_s, kv2048_s, gla_sample)
```

```cpp
#include <hip/hip_runtime.h>
#include <cstdio>
#include <cstdint>
namespace pg8 {
#define PG8_LAS __attribute__((address_space(3)))
typedef unsigned short bf16_t;
typedef short bf16x8 __attribute__((ext_vector_type(8)));
typedef float f32x4 __attribute__((ext_vector_type(4)));
typedef unsigned u32x4 __attribute__((ext_vector_type(4)));
constexpr int BM = 256, BK = 64, HALF = 128, HTB = HALF * BK * 2  , STAGE_BYTES = 8 * HTB, NXCD = 8, WGM = 8;

__host__ __device__ __forceinline__ int lds_byte(int r, int c) { const int st = (r >> 4) * 2 + (c >> 5), rr = r & 15, cc = c & 31, ob = rr * 64 + cc * 2; return st * 1024 + (ob ^ (((ob >> 9) & 1) << 5)); }
__host__ __device__ __forceinline__ void stage_rc(int b, int& R, int& C) { const int st = b / 1024, sb = b % 1024, swz = sb ^ (((sb >> 9) & 1) << 5); R = (st >> 1) * 16 + swz / 64; C = (st & 1) * 32 + (swz % 64) / 2; }
__host__ __device__ __forceinline__ int perm32(int rho) { const int n = rho >> 4, i = rho & 15; return 8 * (i >> 2) + 4 * n + (i & 3); }

struct Unit { int pm, pn; };
struct Gemm { const bf16_t* A; const bf16_t* Bt; int M, N, K; };

struct StaticOrder {
    int nM, nN, nwg, G, c;
    __host__ __device__ void init(int M, int N, int G_, int c_) { nM = M / BM; nN = N / BM; nwg = nM * nN; G = G_; c = c_; }
    __host__ __device__ bool next(int i, Unit& u) const {
        const long L = (long)i * G + c; if (L >= nwg) return false;
        int wgid = (int)L; { const int q = nwg / NXCD, r = nwg % NXCD, xcd = wgid % NXCD, off = wgid / NXCD; wgid = (xcd < r ? xcd * (q + 1) : r * (q + 1) + (xcd - r) * q) + off; }
        const int nig = WGM * nN, gid = wgid / nig, fm = gid * WGM, gsz = (nM - fm) < WGM ? (nM - fm) : WGM;
        u.pm = fm + ((wgid % nig) % gsz); u.pn = (wgid % nig) / gsz; return true;
    }
    __device__ __forceinline__ void a_ready(const Unit&) const {}
    __device__ __forceinline__ void done(const Unit&) const {}
};

__device__ __forceinline__ unsigned cvt_pk_bf16(float lo, float hi) { unsigned r; asm volatile("v_cvt_pk_bf16_f32 %0, %1, %2" : "=v"(r) : "v"(lo), "v"(hi)); return r; }
typedef float f32x2 __attribute__((ext_vector_type(2)));
template <class Epi, class Sched, bool ALIGN_EPI = false, bool SP2 = false>
__device__ __forceinline__ void gemm_phase(PG8_LAS unsigned char* lds, const Gemm g, const Sched& S, const Epi& E) {
    int tid_ = threadIdx.x; asm volatile("" : "+v"(tid_));
    const int tid = tid_, wid = __builtin_amdgcn_readfirstlane(tid >> 6), lane = tid & 63, wr = wid >> 2, wc = wid & 3, fr = lane & 15, fq = lane >> 4;
    const int K = g.K, nt = K / BK;
    unsigned voffA[2], voffB[2];
#pragma unroll
    for (int i = 0; i < 2; ++i) { int R, C; stage_rc(tid * 16 + i * 8192, R, C); const int Rb = Epi::PERM ? ((R & ~31) + perm32(R & 31)) : R;
        voffA[i] = (unsigned)(R * K + C) * 2u; voffB[i] = (unsigned)(Rb * K + C) * 2u; }
    const size_t kstep = (size_t)(BK * 2);
    const size_t hstep = (size_t)HALF * K * 2;
    const size_t tstep = 2 * hstep;
    const unsigned ldsw = (unsigned)wid * 1024u;
    const int aoff = lds_byte(wr * 64 + fr, fq * 8), boff = lds_byte(wc * 32 + fr, fq * 8);
#define PG8_SA(b, h) (((b) * 2 + (h)) * HTB)
#define PG8_SB(b, h) ((4 + (b) * 2 + (h)) * HTB)
#define PG8_STAGE(bufoff, gbase, voff) do { _Pragma("unroll") for (int _i = 0; _i < 2; ++_i) \
        __builtin_amdgcn_global_load_lds((const unsigned*)((const char*)(gbase) + (voff)[_i]), (PG8_LAS unsigned*)(lds + (bufoff) + ldsw + _i * 8192), 16, 0, 0); } while (0)
#define PG8_LDA(dst, b, h) do { _Pragma("unroll") for (int m = 0; m < 4; ++m) _Pragma("unroll") for (int k = 0; k < 2; ++k) dst[m][k] = *(const PG8_LAS bf16x8*)(lds + PG8_SA(b, h) + aoff + m * 2048 + k * 1024); } while (0)
#define PG8_LDB(dst, b, h) do { _Pragma("unroll") for (int n = 0; n < 2; ++n) _Pragma("unroll") for (int k = 0; k < 2; ++k) dst[n][k] = *(const PG8_LAS bf16x8*)(lds + PG8_SB(b, h) + boff + n * 2048 + k * 1024); } while (0)
#define PG8_MMA(ai, bj, At, Bt) do { __builtin_amdgcn_s_setprio(1); _Pragma("unroll") for (int m = 0; m < 4; ++m) _Pragma("unroll") for (int n = 0; n < 2; ++n) _Pragma("unroll") for (int k = 0; k < 2; ++k) \
        acc[ai][bj][m][n] = __builtin_amdgcn_mfma_f32_16x16x32_bf16(Bt[n][k], At[m][k], acc[ai][bj][m][n], 0, 0, 0); __builtin_amdgcn_s_setprio(0); } while (0)
#define PG8_WAIT_V(n) asm volatile("s_waitcnt vmcnt(" #n ")" ::: "memory")
#define PG8_WAIT_L(n) asm volatile("s_waitcnt lgkmcnt(" #n ")" ::: "memory")
#define PG8_BAR __builtin_amdgcn_s_barrier()
#define PG8_SCHED __builtin_amdgcn_sched_barrier(0)
    Unit cur, nxt; int ui = 0;
    if (!S.next(0, cur)) return;
    f32x4 acc[2][2][4][2];
#pragma unroll
    for (int a = 0; a < 2; ++a)
#pragma unroll
        for (int b = 0; b < 2; ++b)
#pragma unroll
            for (int m = 0; m < 4; ++m)
#pragma unroll
                for (int n = 0; n < 2; ++n) acc[a][b][m][n] = (f32x4){0.f, 0.f, 0.f, 0.f};
    bf16x8 At[4][2], B0[2][2], B1[2][2];
    const char* cA = (const char*)g.A + (size_t)cur.pm * tstep; const char* cB = (const char*)g.Bt + (size_t)cur.pn * tstep;
    S.a_ready(cur);
    if constexpr (SP2) {
        PG8_STAGE(PG8_SB(0, 0), cB, voffB); PG8_STAGE(PG8_SB(0, 1), cB + hstep, voffB); PG8_STAGE(PG8_SA(0, 0), cA, voffA); PG8_STAGE(PG8_SA(0, 1), cA + hstep, voffA);
        if (wr == 1) PG8_BAR;
        PG8_WAIT_V(2); PG8_BAR;
        PG8_STAGE(PG8_SB(1, 0), cB + kstep, voffB); PG8_STAGE(PG8_SA(1, 0), cA + kstep, voffA); PG8_STAGE(PG8_SB(1, 1), cB + hstep + kstep, voffB);
        PG8_WAIT_V(6); PG8_BAR;
    } else {
        PG8_STAGE(PG8_SB(0, 0), cB, voffB); PG8_STAGE(PG8_SA(0, 0), cA, voffA); PG8_STAGE(PG8_SB(0, 1), cB + hstep, voffB); PG8_STAGE(PG8_SA(0, 1), cA + hstep, voffA);
        if (wr == 1) PG8_BAR;
        PG8_WAIT_V(4); PG8_BAR;
        PG8_STAGE(PG8_SB(1, 0), cB + kstep, voffB); PG8_STAGE(PG8_SA(1, 0), cA + kstep, voffA); PG8_STAGE(PG8_SB(1, 1), cB + hstep + kstep, voffB);
        PG8_WAIT_V(6); PG8_BAR;
    }
    for (;;) {
        const bool has_next = S.next(ui + 1, nxt);
        const char* nA = has_next ? (const char*)g.A + (size_t)nxt.pm * tstep : cA; const char* nB = has_next ? (const char*)g.Bt + (size_t)nxt.pn * tstep : cB;
        for (int t = 0; t < nt; t += 2) {
            const bool last = (t == nt - 2);
            const char* a1 = cA + (size_t)(t + 1) * kstep;
            const char* a2 = last ? nA : cA + (size_t)(t + 2) * kstep; const char* b2 = last ? nB : cB + (size_t)(t + 2) * kstep;
            const char* a3 = a2 + kstep; const char* b3 = b2 + kstep;
            if (last && has_next) S.a_ready(nxt);
            if constexpr (SP2) {
            PG8_LDB(B0, 0, 0); PG8_LDB(B1, 0, 1); PG8_SCHED; PG8_LDA(At, 0, 0); PG8_STAGE(PG8_SA(1, 1), a1 + hstep, voffA);
            PG8_WAIT_V(8); PG8_WAIT_L(0); PG8_BAR; PG8_MMA(0, 0, At, B0); PG8_MMA(0, 1, At, B1); PG8_BAR; PG8_SCHED;
            PG8_LDA(At, 0, 1); PG8_STAGE(PG8_SB(0, 0), b2, voffB); PG8_STAGE(PG8_SB(0, 1), b2 + hstep, voffB); PG8_STAGE(PG8_SA(0, 0), a2, voffA);
            PG8_WAIT_V(8); PG8_WAIT_L(0); PG8_BAR; PG8_MMA(1, 0, At, B0); PG8_MMA(1, 1, At, B1); PG8_BAR; PG8_SCHED;
            PG8_LDB(B0, 1, 0); PG8_LDB(B1, 1, 1); PG8_SCHED; PG8_LDA(At, 1, 0); PG8_STAGE(PG8_SA(0, 1), a2 + hstep, voffA);
            PG8_WAIT_V(8); PG8_WAIT_L(0); PG8_BAR; PG8_MMA(0, 0, At, B0); PG8_MMA(0, 1, At, B1); PG8_BAR; PG8_SCHED;
            PG8_LDA(At, 1, 1); PG8_STAGE(PG8_SB(1, 0), b3, voffB); PG8_STAGE(PG8_SB(1, 1), b3 + hstep, voffB); PG8_STAGE(PG8_SA(1, 0), a3, voffA);
            PG8_WAIT_V(8); PG8_WAIT_L(0); PG8_BAR; PG8_MMA(1, 0, At, B0); PG8_MMA(1, 1, At, B1); PG8_BAR; PG8_SCHED;
            } else {
            PG8_LDB(B0, 0, 0); PG8_SCHED; PG8_LDA(At, 0, 0); PG8_STAGE(PG8_SA(1, 1), a1 + hstep, voffA);
            PG8_WAIT_L(8); PG8_BAR; PG8_WAIT_L(0); PG8_MMA(0, 0, At, B0); PG8_BAR; PG8_SCHED;
            PG8_LDB(B1, 0, 1); PG8_STAGE(PG8_SB(0, 0), b2, voffB);
            PG8_BAR; PG8_WAIT_L(0); PG8_MMA(0, 1, At, B1); PG8_BAR;
            PG8_LDA(At, 0, 1); PG8_STAGE(PG8_SA(0, 0), a2, voffA);
            PG8_BAR; PG8_WAIT_L(0); PG8_MMA(1, 0, At, B0); PG8_BAR; PG8_SCHED;
            PG8_STAGE(PG8_SB(0, 1), b2 + hstep, voffB);
            PG8_WAIT_V(6); PG8_BAR; PG8_MMA(1, 1, At, B1); PG8_BAR;
            PG8_LDB(B0, 1, 0); PG8_SCHED; PG8_LDA(At, 1, 0); PG8_STAGE(PG8_SA(0, 1), a2 + hstep, voffA);
            PG8_WAIT_L(8); PG8_BAR; PG8_WAIT_L(0); PG8_MMA(0, 0, At, B0); PG8_BAR; PG8_SCHED;
            PG8_LDB(B1, 1, 1); PG8_STAGE(PG8_SB(1, 0), b3, voffB);
            PG8_BAR; PG8_WAIT_L(0); PG8_MMA(0, 1, At, B1); PG8_BAR;
            PG8_LDA(At, 1, 1); PG8_STAGE(PG8_SA(1, 0), a3, voffA);
            PG8_BAR; PG8_WAIT_L(0); PG8_MMA(1, 0, At, B0); PG8_BAR; PG8_SCHED;
            PG8_STAGE(PG8_SB(1, 1), b3 + hstep, voffB);
            PG8_WAIT_V(6); PG8_BAR; PG8_MMA(1, 1, At, B1); PG8_BAR;
            }
        }
        if constexpr (ALIGN_EPI) { if (wr == 0) PG8_BAR; }
        if constexpr (!Epi::AFTER_DRAIN) { E(acc, cur, wr, wc, fr, fq); S.done(cur); }
        if (!has_next) break;
#pragma unroll
        for (int a = 0; a < 2; ++a)
#pragma unroll
            for (int b = 0; b < 2; ++b)
#pragma unroll
                for (int m = 0; m < 4; ++m)
#pragma unroll
                    for (int n = 0; n < 2; ++n) acc[a][b][m][n] = (f32x4){0.f, 0.f, 0.f, 0.f};
        cur = nxt; cA = nA; cB = nB; ++ui;
        if constexpr (ALIGN_EPI) { if (wr == 1) PG8_BAR; }
    }
    PG8_WAIT_V(0);
    if constexpr (!ALIGN_EPI) { if (wr == 0) PG8_BAR; }
    PG8_BAR;
    if constexpr (Epi::AFTER_DRAIN) { E.fused(acc, cur, wr, wc, fr, fq, lds, wid, lane); S.done(cur); }
#undef PG8_SA
#undef PG8_SB
#undef PG8_STAGE
#undef PG8_LDA
#undef PG8_LDB
#undef PG8_MMA
#undef PG8_WAIT_V
#undef PG8_WAIT_L
#undef PG8_BAR
#undef PG8_SCHED
}
}
#define GAS __attribute__((address_space(1)))
#define LAS __attribute__((address_space(3)))
typedef unsigned short bf16;
typedef unsigned v4u __attribute__((ext_vector_type(4)));
typedef float f32x4 __attribute__((ext_vector_type(4)));
typedef short bf16x8 __attribute__((ext_vector_type(8)));
typedef GAS unsigned gu32;
typedef GAS unsigned long long gu64;
#define RLX_AGENT __ATOMIC_RELAXED, __HIP_MEMORY_SCOPE_AGENT
#define LDS_WAIT() asm volatile("s_waitcnt lgkmcnt(0)" ::: "memory")
#define VM_WAIT() asm volatile("s_waitcnt vmcnt(0)" ::: "memory")
__device__ __forceinline__ unsigned long long rt() { return __builtin_amdgcn_s_memrealtime(); }
__device__ __forceinline__ unsigned f2bf(float f) { unsigned u = __builtin_bit_cast(unsigned, f); return (u + 0x7fffu + ((u >> 16) & 1u)) >> 16; }
__device__ __forceinline__ unsigned pk2(float lo, float hi) { return f2bf(lo) | (f2bf(hi) << 16); }

#define XB_TMO      128
#define XB_XCNT(j)  (256  + 64 * (j))
#define XB_XSUB(j)  (1280 + 64 * (j))
#define XB_XGEN(j)  (2304 + 64 * (j))
#define XB_TOP      3328
#define XB_TOPGEN   3392
#define XCD_BAR_WORDS 3456
#define XB_SPIN_CAP (1u << 18)

__device__ __forceinline__ unsigned xb_ld(unsigned* p)              { return __hip_atomic_load(p, __ATOMIC_RELAXED, __HIP_MEMORY_SCOPE_AGENT); }
__device__ __forceinline__ unsigned xb_add(unsigned* p, unsigned v) { return __hip_atomic_fetch_add(p, v, __ATOMIC_RELAXED, __HIP_MEMORY_SCOPE_AGENT); }
__device__ __forceinline__ unsigned xb_xcc_id() { return (unsigned)__builtin_amdgcn_s_getreg((3 << 11) | 20) & 0xFu; }
#define XB_SPIN(cond, bar) do { unsigned _sp = 0; while (cond) { __builtin_amdgcn_s_sleep(1); \
    if ((++_sp & 255u) == 0u) { if (xb_ld(&(bar)[XB_TMO])) break; if (_sp > XB_SPIN_CAP) { atomicAdd(&(bar)[XB_TMO], 1u); break; } } } } while (0)

struct XcdBarrier {
    unsigned* bar; unsigned x;
    volatile LAS unsigned* st;
};

__device__ __forceinline__ XcdBarrier xcd_barrier_post(unsigned* bar, volatile LAS unsigned* st) {
    XcdBarrier b; b.bar = bar; b.x = xb_xcc_id(); b.st = st;
    if (threadIdx.x == 0) (void)xb_add(&bar[XB_XCNT(b.x)], 1u);
    return b;
}
__device__ __forceinline__ void xcd_barrier_complete(unsigned* bar, unsigned x, unsigned& nloc, unsigned& nx) {
    const unsigned G = gridDim.x * gridDim.y * gridDim.z;
    unsigned sum, cnt, mine, sp = 0u;
    for (;;) {
        sum = 0u; cnt = 0u; mine = 0u;
#pragma unroll
        for (unsigned j = 0; j < 16; ++j) { const unsigned c = xb_ld(&bar[XB_XCNT(j)]); sum += c; cnt += (c > 0u) ? 1u : 0u; mine = (j == x) ? c : mine; }
        if (sum == G) break;
        __builtin_amdgcn_s_sleep(1);
        if ((++sp & 255u) == 0u) { if (xb_ld(&bar[XB_TMO])) break; if (sp > XB_SPIN_CAP) { atomicAdd(&bar[XB_TMO], 1u); break; } }
    }
    nloc = mine > 0u ? mine : 1u; nx = cnt > 0u ? cnt : 1u;
}

__device__ __forceinline__ void xcd_barrier(const XcdBarrier& b) {
    asm volatile("s_waitcnt vmcnt(0)" ::: "memory");
    __syncthreads();
    if (threadIdx.x == 0) {
        unsigned* bar = b.bar;
        __builtin_amdgcn_s_waitcnt(0);
        unsigned nloc = b.st[0], nx = b.st[1];
        if (nloc == 0u) { xcd_barrier_complete(bar, b.x, nloc, nx); b.st[0] = nloc; b.st[1] = nx; }
        const unsigned old = xb_add(&bar[XB_XSUB(b.x)], 1u);
        const unsigned gen = old / nloc;
        if (old + 1u == (gen + 1u) * nloc) {
            __builtin_amdgcn_fence(__ATOMIC_RELEASE, "agent");
            asm volatile("s_waitcnt vmcnt(0)" ::: "memory");
            const unsigned og = xb_add(&bar[XB_TOP], 1u);
            const unsigned tg = og / nx;
            if (og + 1u == (tg + 1u) * nx) xb_add(&bar[XB_TOPGEN], 1u);
            else XB_SPIN(xb_ld(&bar[XB_TOPGEN]) == tg, bar);
            __builtin_amdgcn_fence(__ATOMIC_ACQUIRE, "agent");
            xb_add(&bar[XB_XGEN(b.x)], 1u);
            asm volatile("s_waitcnt vmcnt(0)" ::: "memory");
        } else {
            XB_SPIN(xb_ld(&bar[XB_XGEN(b.x)]) == gen, bar);
            __builtin_amdgcn_fence(__ATOMIC_ACQUIRE, "agent");
            asm volatile("s_waitcnt vmcnt(0)" ::: "memory");
        }
    }
    __syncthreads();
}

typedef float f32x16 __attribute__((ext_vector_type(16)));
typedef short v4i16_t __attribute__((ext_vector_type(4)));
typedef float f32x2_t __attribute__((ext_vector_type(2)));
typedef __bf16 bf16x2_t __attribute__((ext_vector_type(2)));

constexpr int DM = 1024, SEQ = 8192, NBATCH = 4, DBATCH = 128, TDEC = 8;
constexpr int MP = NBATCH * SEQ;
constexpr int MS = DBATCH * TDEC;
constexpr int MT = MP + MS;
constexpr int NPROJ = 8704;
constexpr int NIN = 8960;
constexpr int PC_Q = 0, PC_K = 1536, PC_V = 3072, PC_AZ = 4608, PC_GQ = 5120, PC_GK = 5376, PC_GV = 5632, PC_GZ = 6144, PC_MGA = 6656, PC_MGB = 7680;
constexpr float NORM_EPS = 1e-6f;
constexpr float QSCALE = 0.18033688011112042f;
constexpr int NCHUNK = 2048;

constexpr size_t OFF_Y = 0;
constexpr size_t OFF_KVP0 = 34603008, OFF_KVP1 = 35127296, OFF_KVP2 = 37224448, OFF_GLAP = 45613056;
constexpr size_t OFF_KVS0 = 45744128, OFF_KVS1 = 46792704, OFF_KVS2 = 47841280, OFF_GLAS = 48889856, OUT_TOTAL = 53084160;

constexpr size_t MiB = 1u << 20;
constexpr size_t WS_CTL = 0, CTL_ZERO_BYTES = 1 * MiB;
constexpr size_t WS_ROPE = 1 * MiB;
constexpr size_t WS_ROWSS = 2 * MiB;
constexpr size_t WS_WIN = 8 * MiB;
constexpr size_t WS_WA = 26 * MiB, WS_WB = 27 * MiB, WS_WO = 28 * MiB;
constexpr size_t WS_XN = 32 * MiB;
constexpr size_t WS_P = 128 * MiB;
constexpr size_t WS_GLR = 704 * MiB;
constexpr size_t WS_OG = 768 * MiB;
constexpr size_t WS_LSE = 896 * MiB;
constexpr size_t WS_UT = 1024 * MiB;
constexpr size_t WS_DC = 1100 * MiB;
constexpr size_t WS_ST = 1152 * MiB;
constexpr size_t WS_A1 = 1216 * MiB, WS_A2 = 1280 * MiB;
constexpr size_t WS_T1 = 1408 * MiB;
constexpr size_t WS_MIX = 1600 * MiB;
constexpr size_t WS_END = 1700 * MiB;
constexpr int CW_BAR = 4096;

constexpr int RING_OFF = 0, RING_BYTES = 131072;
constexpr int LDSCTL_OFF = RING_BYTES, MISC_OFF = LDSCTL_OFF + 320;
constexpr int LDS_BYTES = 147456;
constexpr int NWAVES = 8;

__device__ __forceinline__ unsigned cvtpk(float lo, float hi) { f32x2_t v = {lo, hi}; bf16x2_t b = __builtin_convertvector(v, bf16x2_t); return __builtin_bit_cast(unsigned, b); }
__device__ __forceinline__ float bf2f(unsigned short u) { return __builtin_bit_cast(float, (unsigned)u << 16); }
__device__ __forceinline__ float bflo(unsigned u) { return __builtin_bit_cast(float, u << 16); }
__device__ __forceinline__ float bfhi(unsigned u) { return __builtin_bit_cast(float, u & 0xffff0000u); }
__device__ __forceinline__ float sigmoidf_(float x) { return 1.0f / (1.0f + __expf(-x)); }
__device__ __forceinline__ float siluf_(float x) { return x / (1.0f + __expf(-x)); }
__device__ __forceinline__ float logsigf_(float x) { return fminf(x, 0.f) - log1pf(__expf(-fabsf(x))); }
__device__ __forceinline__ int crow(int r, int hi) { return (r & 3) + 8 * (r >> 2) + 4 * hi; }
__device__ __forceinline__ float wave_sum(float v) {
#pragma unroll
    for (int o = 1; o < 64; o <<= 1) v += __shfl_xor(v, o);
    return v;
}
#define WG_BAR() do { asm volatile("s_waitcnt vmcnt(0) lgkmcnt(0)" ::: "memory"); __builtin_amdgcn_s_barrier(); asm volatile("" ::: "memory"); } while (0)

struct Args {
    const float* xp; const float* xs; const float* c128; const float* c512; const float* c2048; const float* sgla;
    const float* lnw; const float* win; const float* wa2; const float* ba; const float* gnw; const float* wao; const float* wgo; const float* wout; const float* fnw;
    float* out; unsigned char* ws;
};

struct EpiProj {
    static constexpr bool PERM = true, AFTER_DRAIN = false;
    bf16* P; float* glr; const float* rc; const float* rs; float* out;
    __device__ __forceinline__ void operator()(const pg8::f32x4 (&acc)[2][2][4][2], const pg8::Unit& u, int wr, int wc, int fr, int fq) const {
        const int pn = u.pn; const int row0 = u.pm * 256 + wr * 64 + fr;
        if (pn == 34) {
            if (wc == 0 && fq < 2) {
#pragma unroll
                for (int ai = 0; ai < 2; ++ai)
#pragma unroll
                    for (int m = 0; m < 4; ++m) { const int row = row0 + ai * 128 + m * 16; float* g = glr + (size_t)row * 16 + 8 * fq;
                        *(f32x4*)g = acc[ai][0][m][0]; *(f32x4*)(g + 4) = acc[ai][0][m][1]; }
            }
            return;
        }
        const int kind = pn < 6 ? 0 : (pn < 12 ? 1 : (pn < 18 ? 2 : 3));
        const bool rope = (kind <= 1) && ((wc & 1) == 0);
        const int colb = pn * 256 + wc * 32 + 8 * fq;
        const int g = (kind == 1) ? ((pn - 6) >> 1) : ((pn - 12) >> 1);
        const int W = 128 << (2 * g);
        const size_t offp = (g == 0) ? OFF_KVP0 : (g == 1 ? OFF_KVP1 : OFF_KVP2);
        const size_t offs = (g == 0) ? OFF_KVS0 : (g == 1 ? OFF_KVS1 : OFF_KVS2);
#pragma unroll
        for (int ai = 0; ai < 2; ++ai)
#pragma unroll
            for (int m = 0; m < 4; ++m) {
                const int row = row0 + ai * 128 + m * 16;
                f32x4 cA = {1.f, 1.f, 1.f, 1.f}, cB = cA, sA = {0.f, 0.f, 0.f, 0.f}, sB = sA;
                if (rope) { const int pos = row < MP ? (row & (SEQ - 1)) : SEQ + ((row - MP) & 7);
                    cA = *(const f32x4*)(rc + pos * 8); cB = *(const f32x4*)(rc + pos * 8 + 4); sA = *(const f32x4*)(rs + pos * 8); sB = *(const f32x4*)(rs + pos * 8 + 4); }
#pragma unroll
                for (int bj = 0; bj < 2; ++bj) {
                    f32x4 v0 = acc[ai][bj][m][0], v1 = acc[ai][bj][m][1];
                    if (rope) {
                        f32x4 p0, p1;
#pragma unroll
                        for (int e = 0; e < 4; ++e) { p0[e] = __shfl_xor(v0[e], 16); p1[e] = __shfl_xor(v1[e], 16); }
                        if (fq == 0) { v0 = v0 * cA - p0 * sA; v1 = v1 * cB - p1 * sB; }
                        else if (fq == 1) { v0 = v0 * cA + p0 * sA; v1 = v1 * cB + p1 * sB; }
                    }
                    if (kind == 1 || kind == 2) {
                        const int cg = (pn & 1) * 256 + bj * 128 + wc * 32 + 8 * fq; const int kvsel = kind - 1;
                        if (row < MP) { const int b = row >> 13, t = row & (SEQ - 1);
                            if (t >= SEQ - W) { float* dst = out + offp + ((size_t)(b * W + (t - (SEQ - W))) * 2 + kvsel) * 512 + cg; *(f32x4*)dst = v0; *(f32x4*)(dst + 4) = v1; } }
                        else { float* dst = out + offs + (size_t)(row - MP) * 1024 + kvsel * 512 + cg; *(f32x4*)dst = v0; *(f32x4*)(dst + 4) = v1; }
                    }
                    if (kind == 0) { v0 = v0 * QSCALE; v1 = v1 * QSCALE; }
                    v4u w; w.x = cvtpk(v0[0], v0[1]); w.y = cvtpk(v0[2], v0[3]); w.z = cvtpk(v1[0], v1[1]); w.w = cvtpk(v1[2], v1[3]);
                    *(v4u*)(P + (size_t)row * NPROJ + colb + bj * 128) = w;
                }
            }
    }
};
struct EpiGateA {
    static constexpr bool PERM = true, AFTER_DRAIN = false;
    const bf16* P; float* T1;
    __device__ __forceinline__ void operator()(const pg8::f32x4 (&acc)[2][2][4][2], const pg8::Unit& u, int wr, int wc, int fr, int fq) const {
        const int row0 = u.pm * 256 + wr * 64 + fr, colb = u.pn * 256 + wc * 32 + 8 * fq;
#pragma unroll
        for (int ai = 0; ai < 2; ++ai)
#pragma unroll
            for (int m = 0; m < 4; ++m) { const int row = row0 + ai * 128 + m * 16;
#pragma unroll
                for (int bj = 0; bj < 2; ++bj) { const int col = colb + bj * 128;
                    const v4u gw = *(const v4u*)(P + (size_t)row * NPROJ + PC_MGA + col);
                    f32x4 v0 = acc[ai][bj][m][0], v1 = acc[ai][bj][m][1];
                    v0[0] *= sigmoidf_(bflo(gw.x)); v0[1] *= sigmoidf_(bfhi(gw.x)); v0[2] *= sigmoidf_(bflo(gw.y)); v0[3] *= sigmoidf_(bfhi(gw.y));
                    v1[0] *= sigmoidf_(bflo(gw.z)); v1[1] *= sigmoidf_(bfhi(gw.z)); v1[2] *= sigmoidf_(bflo(gw.w)); v1[3] *= sigmoidf_(bfhi(gw.w));
                    float* dst = T1 + (size_t)row * 1024 + col; *(f32x4*)dst = v0; *(f32x4*)(dst + 4) = v1; } }
    }
};
struct EpiGateB {
    static constexpr bool PERM = true, AFTER_DRAIN = false;
    const bf16* P; const float* T1; bf16* MIX;
    __device__ __forceinline__ void operator()(const pg8::f32x4 (&acc)[2][2][4][2], const pg8::Unit& u, int wr, int wc, int fr, int fq) const {
        const int row0 = u.pm * 256 + wr * 64 + fr, colb = u.pn * 256 + wc * 32 + 8 * fq;
#pragma unroll
        for (int ai = 0; ai < 2; ++ai)
#pragma unroll
            for (int m = 0; m < 4; ++m) { const int row = row0 + ai * 128 + m * 16;
#pragma unroll
                for (int bj = 0; bj < 2; ++bj) { const int col = colb + bj * 128;
                    const v4u gw = *(const v4u*)(P + (size_t)row * NPROJ + PC_MGB + col);
                    const float* src = T1 + (size_t)row * 1024 + col; const f32x4 t0 = *(const f32x4*)src, t1 = *(const f32x4*)(src + 4);
                    f32x4 v0 = acc[ai][bj][m][0], v1 = acc[ai][bj][m][1];
                    v0[0] = t0[0] + v0[0] * sigmoidf_(bflo(gw.x)); v0[1] = t0[1] + v0[1] * sigmoidf_(bfhi(gw.x)); v0[2] = t0[2] + v0[2] * sigmoidf_(bflo(gw.y)); v0[3] = t0[3] + v0[3] * sigmoidf_(bfhi(gw.y));
                    v1[0] = t1[0] + v1[0] * sigmoidf_(bflo(gw.z)); v1[1] = t1[1] + v1[1] * sigmoidf_(bfhi(gw.z)); v1[2] = t1[2] + v1[2] * sigmoidf_(bflo(gw.w)); v1[3] = t1[3] + v1[3] * sigmoidf_(bfhi(gw.w));
                    v4u w; w.x = cvtpk(v0[0], v0[1]); w.y = cvtpk(v0[2], v0[3]); w.z = cvtpk(v1[0], v1[1]); w.w = cvtpk(v1[2], v1[3]);
                    *(v4u*)(MIX + (size_t)row * 1024 + col) = w; } }
    }
};
struct EpiResid {
    static constexpr bool PERM = false, AFTER_DRAIN = false;
    const float* xp; const float* xs; float* out; float* rowss;
    __device__ __forceinline__ void operator()(const pg8::f32x4 (&acc)[2][2][4][2], const pg8::Unit& u, int wr, int wc, int fr, int fq) const {
        const int row0 = u.pm * 256 + wr * 64 + fr, colb = u.pn * 256 + wc * 32 + 4 * fq;
#pragma unroll
        for (int ai = 0; ai < 2; ++ai)
#pragma unroll
            for (int m = 0; m < 4; ++m) { const int row = row0 + ai * 128 + m * 16;
                const float* xr = row < MP ? xp + (size_t)row * 1024 : xs + (size_t)(row - MP) * 1024;
                float ss = 0.f;
#pragma unroll
                for (int bj = 0; bj < 2; ++bj)
#pragma unroll
                    for (int n = 0; n < 2; ++n) { const int col = colb + bj * 128 + n * 16;
                        const f32x4 o = *(const f32x4*)(xr + col) + acc[ai][bj][m][n];
                        *(f32x4*)(out + (size_t)row * 1024 + col) = o;
                        ss += (o[0] * o[0] + o[1] * o[1]) + (o[2] * o[2] + o[3] * o[3]); }
                ss += __shfl_xor(ss, 16); ss += __shfl_xor(ss, 32);
                if (fq == 0) rowss[(size_t)row * 16 + u.pn * 4 + wc] = ss; }
    }
};

struct Frame {
    LAS unsigned char* lds; volatile LAS unsigned* MISC; gu32* ctl;
    int tid, lane, wave, G, bid;
};

__device__ __forceinline__ void p0_tr_item(const float* W, int ldw, int K, bf16* WT, int r0, int c0, int nvalid, int k0, LAS float* scr, int lane) {
    const int j32 = lane & 31;
#pragma unroll 8
    for (int i = 0; i < 32; ++i) { const int kk = 2 * i + (lane >> 5); scr[kk * 33 + j32] = (j32 < nvalid) ? W[(size_t)(k0 + kk) * ldw + c0 + j32] : 0.f; }
    LDS_WAIT(); asm volatile("" ::: "memory");
    const int c = lane & 7;
#pragma unroll
    for (int j = 0; j < 4; ++j) { const int n = (lane >> 3) + 8 * j; const LAS float* s = scr + (8 * c) * 33 + n;
        v4u o; o.x = pk2(s[0 * 33], s[1 * 33]); o.y = pk2(s[2 * 33], s[3 * 33]); o.z = pk2(s[4 * 33], s[5 * 33]); o.w = pk2(s[6 * 33], s[7 * 33]);
        *(v4u*)(WT + (size_t)(r0 + n) * K + k0 + 8 * c) = o; }
    LDS_WAIT(); asm volatile("" ::: "memory");
}
__device__ __forceinline__ void sincos_acc(double a, float& s, float& c) {
    const double k = rint(a * 0.15915494309189533577); const double r = a - k * 6.283185307179586476925;
    const double r2 = r * r;
    double cs = 0.0, sn = 0.0, tc = 1.0, ts = r;
#pragma unroll
    for (int n = 0; n < 15; ++n) { cs += tc; sn += ts; tc = -tc * r2 / (double)((2 * n + 1) * (2 * n + 2)); ts = -ts * r2 / (double)((2 * n + 2) * (2 * n + 3)); }
    s = (float)sn; c = (float)cs;
}
__device__ __forceinline__ void p0_prologue(Frame& F, const Args& a, unsigned char* ws, float* outp) {
    LAS float* scr = (LAS float*)(F.lds + RING_OFF + F.wave * 16384);
    const int gw = F.bid * NWAVES + F.wave, NGW = F.G * NWAVES;
    bf16* Win = (bf16*)(ws + WS_WIN); bf16* Wa = (bf16*)(ws + WS_WA); bf16* Wb = (bf16*)(ws + WS_WB); bf16* Wo = (bf16*)(ws + WS_WO);
    constexpr int I_IN = 16 * 280, I_A = 8 * 32, I_B = 8 * 32, I_O = 16 * 32, NITEMS = I_IN + I_A + I_B + I_O;
    for (int it = gw; it < NITEMS; it += NGW) {
        int r = it;
        if (r < I_IN) { const int kb = r / 280, nb = r % 280, r0 = 32 * nb; int c0, nv;
            if (r0 < 6656) { c0 = r0; nv = 32; } else if (r0 < 8704) { c0 = r0 + 16; nv = 32; } else if (r0 == 8704) { c0 = 6656; nv = 16; } else { c0 = 0; nv = 0; }
            p0_tr_item(a.win, 8720, 1024, Win, r0, c0, nv, 64 * kb, scr, F.lane); continue; }
        r -= I_IN;
        if (r < I_A) { p0_tr_item(a.wao, 1024, 512, Wa, 32 * (r % 32), 32 * (r % 32), 32, 64 * (r / 32), scr, F.lane); continue; }
        r -= I_A;
        if (r < I_B) { p0_tr_item(a.wgo, 1024, 512, Wb, 32 * (r % 32), 32 * (r % 32), 32, 64 * (r / 32), scr, F.lane); continue; }
        r -= I_B;
        p0_tr_item(a.wout, 1024, 1024, Wo, 32 * (r % 32), 32 * (r % 32), 32, 64 * (r / 32), scr, F.lane);
    }
    bf16* XN = (bf16*)(ws + WS_XN);
    f32x4 lw[4];
#pragma unroll
    for (int j = 0; j < 4; ++j) lw[j] = *((const f32x4*)a.lnw + F.lane + 64 * j);
    for (int m = gw; m < MT; m += NGW) {
        const float* xrow = m < MP ? a.xp + (size_t)m * DM : a.xs + (size_t)(m - MP) * DM;
        const f32x4* xr = (const f32x4*)xrow + F.lane;
        f32x4 v[4]; float s = 0.f;
#pragma unroll
        for (int j = 0; j < 4; ++j) { v[j] = xr[64 * j]; s += (v[j].x * v[j].x + v[j].y * v[j].y) + (v[j].z * v[j].z + v[j].w * v[j].w); }
        const float rstd = 1.0f / sqrtf(wave_sum(s) * (1.f / DM) + NORM_EPS);
        unsigned long long* o8 = (unsigned long long*)(XN + (size_t)m * DM) + F.lane;
#pragma unroll
        for (int j = 0; j < 4; ++j) { const f32x4 y = v[j] * rstd * lw[j]; o8[64 * j] = (unsigned long long)cvtpk(y.x, y.y) | ((unsigned long long)cvtpk(y.z, y.w) << 32); }
    }
    float* rc = (float*)(ws + WS_ROPE); float* rs = rc + 8200 * 8;
    for (int idx = F.bid * 512 + F.tid; idx < 8200 * 8; idx += F.G * 512) {
        const int pos = idx >> 3, i = idx & 7;
        const double f = (i == 0) ? 1.0 : (i == 1) ? 0.19392274474868576 : (i == 2) ? 0.03760603093086393 : (i == 3) ? 0.007292664737217109 : (i == 4) ? 0.001414213562373095 :
                         (i == 5) ? 0.0002742481756762073 : (i == 6) ? 5.318295896944988e-05 : 1.031338537721246e-05;
        float s, c; sincos_acc((double)pos * f, s, c); rc[idx] = c; rs[idx] = s;
    }
}

__device__ __forceinline__ bf16x8 pack8(const f32x16& x, int s8) {
    v4u p; p.x = cvtpk(x[s8 + 0], x[s8 + 1]); p.y = cvtpk(x[s8 + 2], x[s8 + 3]); p.z = cvtpk(x[s8 + 4], x[s8 + 5]); p.w = cvtpk(x[s8 + 6], x[s8 + 7]);
    return __builtin_bit_cast(bf16x8, p);
}
template <bool SB, class KF, class VF, class MK>
__device__ __forceinline__ void attn_wave(const bf16x8 (&qf)[4], const KF& kf, const VF& vf, const MK& valid, int lane, f32x16 (&o)[2], float& lse2) {
    const int q = lane & 31, hi = lane >> 5;
    f32x16 x[5];
#pragma unroll
    for (int j = 0; j < 5; ++j) {
#pragma unroll
        for (int r = 0; r < 16; ++r) x[j][r] = 0.f;
#pragma unroll
        for (int d0 = 0; d0 < 4; ++d0) x[j] = __builtin_amdgcn_mfma_f32_32x32x16_bf16(kf(j, d0), qf[d0], x[j], 0, 0, 0);
        if (SB) __builtin_amdgcn_sched_barrier(0);
    }
    float m = -1e30f;
#pragma unroll
    for (int j = 0; j < 5; ++j)
#pragma unroll
        for (int r = 0; r < 16; ++r) { const bool ok = valid(q, 32 * j + crow(r, hi)); const float v = ok ? x[j][r] : -1e30f; x[j][r] = v; m = fmaxf(m, v); }
    m = fmaxf(m, __shfl_xor(m, 32));
    float l = 0.f;
#pragma unroll
    for (int j = 0; j < 5; ++j)
#pragma unroll
        for (int r = 0; r < 16; ++r) { const float p = __builtin_amdgcn_exp2f(x[j][r] - m); x[j][r] = p; l += p; }
    l += __shfl_xor(l, 32);
#pragma unroll
    for (int r = 0; r < 16; ++r) { o[0][r] = 0.f; o[1][r] = 0.f; }
#pragma unroll
    for (int j = 0; j < 5; ++j)
#pragma unroll
        for (int s = 0; s < 2; ++s) { const bf16x8 pa = pack8(x[j], 8 * s);
#pragma unroll
            for (int c = 0; c < 2; ++c) o[c] = __builtin_amdgcn_mfma_f32_32x32x16_bf16(pa, vf(j, s, c), o[c], 0, 0, 0);
            if (SB) __builtin_amdgcn_sched_barrier(0); }
    lse2 = m + __log2f(l);
#pragma unroll
    for (int r = 0; r < 16; ++r) { const float li = __shfl(l, crow(r, hi)); const float inv = 1.0f / li; o[0][r] *= inv; o[1][r] *= inv; }
}

constexpr int ATT_PITCH = 144;
constexpr int ATT_KOFF = 0, ATT_VOFF = 384 * ATT_PITCH;
__device__ __forceinline__ void attn_prompt_unit(Frame& F, const Args& a, int u, unsigned char* ws, float* outp) {
    const bf16* P = (const bf16*)(ws + WS_P); bf16* OG = (bf16*)(ws + WS_OG); float* LSE = (float*)(ws + WS_LSE);
    const int g = u >> 10, rem = u & 1023, b = rem >> 8, rq = (rem & 255) >> 3, h = rem & 7;
    const int d = 1 << (2 * g);
    const int nqb = 32 >> (2 * g);
    const int r = rq / nqb, qb = rq % nqb;
    const int l0 = qb * 256;
    const size_t rowb = (size_t)b * SEQ + r;
    LAS unsigned char* Kl = F.lds + ATT_KOFF; LAS unsigned char* Vl = F.lds + ATT_VOFF;
#pragma unroll
    for (int i = 0; i < 6; ++i) { const int ci = F.tid + 512 * i, row = ci >> 3, ch = ci & 7; const int l = l0 - 128 + row;
        v4u kv = {0u, 0u, 0u, 0u}, vv = {0u, 0u, 0u, 0u};
        if (l >= 0) { const bf16* src = P + (rowb + (size_t)d * l) * NPROJ + g * 512 + h * 64 + ch * 8; kv = *(const v4u*)(src + PC_K); vv = *(const v4u*)(src + PC_V); }
        *(LAS v4u*)(Kl + row * ATT_PITCH + ch * 16) = kv; *(LAS v4u*)(Vl + row * ATT_PITCH + ch * 16) = vv; }
    const int w = F.wave, lane = F.lane, hi = lane >> 5, q = lane & 31;
    bf16x8 qf[4];
    { const bf16* qsrc = P + (rowb + (size_t)d * (l0 + 32 * w + q)) * NPROJ + PC_Q + g * 512 + h * 64 + 8 * hi;
#pragma unroll
      for (int d0 = 0; d0 < 4; ++d0) qf[d0] = *(const bf16x8*)(qsrc + 16 * d0); }
    WG_BAR();
    const LAS unsigned char* kb = Kl + (32 * w + q) * ATT_PITCH + hi * 16;
    const int q_ = (lane & 15) >> 2, p_ = lane & 3, blk = (lane >> 4) & 1;
    const LAS unsigned char* vb = Vl + (32 * w + 4 * hi + q_) * ATT_PITCH + (16 * blk + 4 * p_) * 2;
    auto kf = [&](int j, int d0) __attribute__((always_inline)) -> bf16x8 { return *(const LAS bf16x8*)(kb + j * 32 * ATT_PITCH + d0 * 32); };
    auto vf = [&](int j, int s, int c) __attribute__((always_inline)) -> bf16x8 {
        const LAS unsigned char* p = vb + (32 * j + 16 * s) * ATT_PITCH + c * 64;
        const v4i16_t lo = __builtin_amdgcn_ds_read_tr16_b64_v4i16((LAS v4i16_t*)p);
        const v4i16_t hh = __builtin_amdgcn_ds_read_tr16_b64_v4i16((LAS v4i16_t*)(p + 8 * ATT_PITCH));
        return (bf16x8){lo[0], lo[1], lo[2], lo[3], hh[0], hh[1], hh[2], hh[3]}; };
    const int kpos0 = l0 + 32 * w - 128;
    auto valid = [&](int qq, int kk) __attribute__((always_inline)) -> bool { const int dist = qq + 128 - kk; return dist >= 0 && dist <= 128 && (kpos0 + kk) >= 0; };
    f32x16 o[2]; float lse2;
    attn_wave<false>(qf, kf, vf, valid, lane, o, lse2);
    const size_t orow0 = (size_t)g * MT + rowb + (size_t)d * (l0 + 32 * w);
#pragma unroll
    for (int rr = 0; rr < 16; ++rr) { const int qq = crow(rr, hi); bf16* dst = OG + (orow0 + (size_t)d * qq) * 512 + h * 64 + q;
        dst[0] = (bf16)(cvtpk(o[0][rr], 0.f) & 0xffffu); dst[32] = (bf16)(cvtpk(o[1][rr], 0.f) & 0xffffu); }
    if (hi == 0) LSE[(orow0 + (size_t)d * q) * 8 + h] = lse2;
    WG_BAR();
}
__device__ __forceinline__ void attn_sample_unit(Frame& F, const Args& a, int su, unsigned char* ws, float* outp) {
    const bf16* P = (const bf16*)(ws + WS_P); bf16* OG = (bf16*)(ws + WS_OG); float* LSE = (float*)(ws + WS_LSE);
    const int db = su / 13, k13 = su % 13;
    const int g = k13 == 0 ? 0 : (k13 < 5 ? 1 : 2);
    const int sub = k13 == 0 ? 0 : (k13 < 5 ? k13 - 1 : k13 - 5);
    const int d = 1 << (2 * g), nq = 8 >> (g == 0 ? 0 : (g == 1 ? 2 : 3));
    const int Wlen = 128 << (2 * g);
    const float* cp0 = a.c128; const float* cp1 = a.c512; const float* cp2 = a.c2048; { size_t z_ = 0; asm volatile("" : "+s"(z_)); cp0 += z_; cp1 += z_; cp2 += z_; }
    const float* cache = g == 0 ? cp0 : (g == 1 ? cp1 : cp2);
    const int h = F.wave, lane = F.lane, hi = lane >> 5, q = lane & 31;
    const float* kc = cache + (size_t)db * Wlen * 1024 + h * 64;
    const size_t srow0 = (size_t)MP + db * 8;
    bf16x8 qf[4];
    { const bf16* qsrc = P + (srow0 + sub + d * q) * NPROJ + PC_Q + g * 512 + h * 64 + 8 * hi;
#pragma unroll
      for (int d0 = 0; d0 < 4; ++d0) { bf16x8 z = {0, 0, 0, 0, 0, 0, 0, 0}; if (q < nq) z = *(const bf16x8*)(qsrc + 16 * d0); qf[d0] = z; } }
    auto kf = [&](int j, int d0) __attribute__((always_inline)) -> bf16x8 {
        if (j < 4) { const float* p = kc + (size_t)(sub + d * (32 * j + q)) * 1024 + 16 * d0 + 8 * hi; const f32x4 x0 = *(const f32x4*)p, x1 = *(const f32x4*)(p + 4);
            v4u w; w.x = cvtpk(x0[0], x0[1]); w.y = cvtpk(x0[2], x0[3]); w.z = cvtpk(x1[0], x1[1]); w.w = cvtpk(x1[2], x1[3]); return __builtin_bit_cast(bf16x8, w); }
        bf16x8 z = {0, 0, 0, 0, 0, 0, 0, 0};
        if (q < nq) z = *(const bf16x8*)(P + (srow0 + sub + d * q) * NPROJ + PC_K + g * 512 + h * 64 + 16 * d0 + 8 * hi);
        return z; };
    auto vf = [&](int j, int s, int c) __attribute__((always_inline)) -> bf16x8 {
        float f[8];
#pragma unroll
        for (int jj = 0; jj < 8; ++jj) { const int kr = 16 * s + 8 * (jj >> 2) + 4 * hi + (jj & 3);
            if (j < 4) f[jj] = kc[(size_t)(sub + d * (32 * j + kr)) * 1024 + 512 + 32 * c + q];
            else { float t = 0.f; if (kr < 8 && kr < nq) t = bf2f(P[(srow0 + sub + d * kr) * NPROJ + PC_V + g * 512 + h * 64 + 32 * c + q]); f[jj] = t; } }
        v4u w; w.x = cvtpk(f[0], f[1]); w.y = cvtpk(f[2], f[3]); w.z = cvtpk(f[4], f[5]); w.w = cvtpk(f[6], f[7]); return __builtin_bit_cast(bf16x8, w); };
    auto valid = [&](int qq, int slot) __attribute__((always_inline)) -> bool { return qq < nq && (slot < 128 ? slot >= qq : ((slot - 128) <= qq && (slot - 128) < nq)); };
    f32x16 o[2]; float lse2;
    attn_wave<true>(qf, kf, vf, valid, lane, o, lse2);
    const size_t orow0 = (size_t)g * MT + srow0 + sub;
#pragma unroll
    for (int rr = 0; rr < 4; ++rr) { const int qq = crow(rr, hi);
        if (qq < nq) { bf16* dst = OG + (orow0 + (size_t)d * qq) * 512 + h * 64 + q; dst[0] = (bf16)(cvtpk(o[0][rr], 0.f) & 0xffffu); dst[32] = (bf16)(cvtpk(o[1][rr], 0.f) & 0xffffu); } }
    if (hi == 0 && q < nq) LSE[(orow0 + (size_t)d * q) * 8 + h] = lse2;
}

constexpr int GP = 72;
__device__ __forceinline__ void gla_gates(const Args& a, const float* glr_rows, int h, int wave, int lane, LAS float* tot, float (&b)[8], float& blast) {
    float wa[16];
#pragma unroll
    for (int r = 0; r < 16; ++r) wa[r] = a.wa2[r * 256 + h * 64 + lane];
    const float bias = a.ba[h * 64 + lane];
    float run = 0.f;
#pragma unroll
    for (int i = 0; i < 8; ++i) { const f32x4* gp4 = (const f32x4*)(glr_rows + (size_t)(8 * wave + i) * 16); float gp = bias;
#pragma unroll
        for (int r4 = 0; r4 < 4; ++r4) { const f32x4 gv = gp4[r4]; gp += gv[0] * wa[4 * r4] + gv[1] * wa[4 * r4 + 1] + gv[2] * wa[4 * r4 + 2] + gv[3] * wa[4 * r4 + 3]; }
        run += logsigf_(gp) * (1.0f / 16.0f); b[i] = run; }
    tot[wave * 64 + lane] = run;
    WG_BAR();
    float pre = 0.f, all = 0.f;
#pragma unroll
    for (int s = 0; s < 8; ++s) { const float tv = tot[s * 64 + lane]; all += tv; pre += (s < wave) ? tv : 0.f; }
#pragma unroll
    for (int i = 0; i < 8; ++i) b[i] += pre;
    blast = all;
}
__device__ __forceinline__ void gla_stage_vT(Frame& F, const bf16* P, size_t row0, int h, LAS bf16* vT) {
    const int v = F.tid & 127, tq = F.tid >> 7;
    unsigned pk[8];
#pragma unroll
    for (int i = 0; i < 8; ++i) { const unsigned lo = P[(row0 + 16 * tq + 2 * i) * NPROJ + PC_GV + h * 128 + v], hi2 = P[(row0 + 16 * tq + 2 * i + 1) * NPROJ + PC_GV + h * 128 + v]; pk[i] = lo | (hi2 << 16); }
    LAS v4u* dst = (LAS v4u*)((LAS unsigned char*)vT + v * (GP * 2) + 32 * tq);
    dst[0] = (v4u){pk[0], pk[1], pk[2], pk[3]}; dst[1] = (v4u){pk[4], pk[5], pk[6], pk[7]};
}
__device__ __forceinline__ bf16x8 ldfrag(const LAS bf16* base, int row, int kofs) { return *(const LAS bf16x8*)(base + row * GP + kofs); }

__device__ __forceinline__ void gla_g1_unit(Frame& F, const Args& a, int chunk, unsigned char* ws, float* outp) {
    const bf16* P = (const bf16*)(ws + WS_P); const float* GLR = (const float*)(ws + WS_GLR); float* UT = (float*)(ws + WS_UT); float* DC = (float*)(ws + WS_DC);
    const int bh = chunk >> 7, c = chunk & 127, b = bh >> 2, h = bh & 3;
    const size_t row0 = (size_t)b * SEQ + c * 64;
    LAS bf16* kdT = (LAS bf16*)(F.lds + 0);
    LAS bf16* vT = (LAS bf16*)(F.lds + 9216);
    LAS float* tot = (LAS float*)(F.lds + 27648);
    const int lane = F.lane, w = F.wave, hi = lane >> 5;
    float bb[8], blast;
    gla_gates(a, GLR + row0 * 16, h, w, lane, tot, bb, blast);
    { unsigned pk[4];
#pragma unroll
      for (int i = 0; i < 4; ++i) { const float k0 = bf2f(P[(row0 + 8 * w + 2 * i) * NPROJ + PC_GK + h * 64 + lane]) * __expf(blast - bb[2 * i]);
          const float k1 = bf2f(P[(row0 + 8 * w + 2 * i + 1) * NPROJ + PC_GK + h * 64 + lane]) * __expf(blast - bb[2 * i + 1]); pk[i] = cvtpk(k0, k1); }
      *(LAS v4u*)((LAS unsigned char*)kdT + lane * (GP * 2) + 16 * w) = (v4u){pk[0], pk[1], pk[2], pk[3]}; }
    gla_stage_vT(F, P, row0, h, vT);
    if (w == 0) DC[(size_t)chunk * 64 + lane] = __expf(blast);
    WG_BAR();
    const int vt = w >> 1, kt = w & 1;
    f32x16 acc;
#pragma unroll
    for (int r = 0; r < 16; ++r) acc[r] = 0.f;
#pragma unroll
    for (int s = 0; s < 4; ++s) acc = __builtin_amdgcn_mfma_f32_32x32x16_bf16(ldfrag(vT, 32 * vt + (lane & 31), 16 * s + 8 * hi), ldfrag(kdT, 32 * kt + (lane & 31), 16 * s + 8 * hi), acc, 0, 0, 0);
    float* ut = UT + (size_t)chunk * 8192;
#pragma unroll
    for (int r = 0; r < 16; ++r) ut[(32 * vt + crow(r, hi)) * 64 + 32 * kt + (lane & 31)] = acc[r];
    WG_BAR();
}
__device__ __forceinline__ void gla_scan(Frame& F, const Args& a, unsigned char* ws, float* outp) {
    const float* UT = (const float*)(ws + WS_UT); const float* DC = (const float*)(ws + WS_DC); bf16* ST = (bf16*)(ws + WS_ST);
    for (int e = F.bid * 512 + F.tid; e < 16 * 8192; e += F.G * 512) {
        const int bh = e >> 13, vk = e & 8191, v = vk >> 6, k = vk & 63;
        const float* ut = UT + (size_t)bh * 128 * 8192 + vk; const float* dc = DC + (size_t)bh * 128 * 64 + k; bf16* st = ST + (size_t)bh * 128 * 8192 + vk;
        float S = 0.f;
        for (int c0 = 0; c0 < 128; c0 += 16) {
            float uu[16], dd[16];
#pragma unroll
            for (int i = 0; i < 16; ++i) { uu[i] = ut[(size_t)(c0 + i) * 8192]; dd[i] = dc[(c0 + i) * 64]; }
#pragma unroll
            for (int i = 0; i < 16; ++i) { st[(size_t)(c0 + i) * 8192] = (bf16)(cvtpk(S, 0.f) & 0xffffu); S = dd[i] * S + uu[i]; }
        }
        outp[OFF_GLAP + ((size_t)bh * 64 + k) * 128 + v] = S;
    }
}
__device__ __forceinline__ void gla_g3_unit(Frame& F, const Args& a, int chunk, unsigned char* ws, float* outp) {
    const bf16* P = (const bf16*)(ws + WS_P); const float* GLR = (const float*)(ws + WS_GLR); const bf16* ST = (const bf16*)(ws + WS_ST); bf16* A2 = (bf16*)(ws + WS_A2);
    const int bh = chunk >> 7, c = chunk & 127, b = bh >> 2, h = bh & 3;
    const size_t row0 = (size_t)b * SEQ + c * 64;
    LAS bf16* qeL = (LAS bf16*)(F.lds + 0); LAS bf16* keL = (LAS bf16*)(F.lds + 9216); LAS bf16* attL = (LAS bf16*)(F.lds + 18432);
    LAS bf16* vT = (LAS bf16*)(F.lds + 27648); LAS bf16* sTL = (LAS bf16*)(F.lds + 46080); LAS float* tot = (LAS float*)(F.lds + 64512); LAS float* oL = (LAS float*)(F.lds + 66560);
    const int lane = F.lane, w = F.wave, hi = lane >> 5;
    float bb[8], blast;
    gla_gates(a, GLR + row0 * 16, h, w, lane, tot, bb, blast);
#pragma unroll
    for (int i = 0; i < 8; ++i) { const size_t pr = (row0 + 8 * w + i) * NPROJ + h * 64 + lane;
        const float qv = bf2f(P[pr + PC_GQ]) * 0.125f * __expf(bb[i]); const float kv = bf2f(P[pr + PC_GK]) * __expf(-bb[i]);
        qeL[(8 * w + i) * GP + lane] = (bf16)(cvtpk(qv, 0.f) & 0xffffu); keL[(8 * w + i) * GP + lane] = (bf16)(cvtpk(kv, 0.f) & 0xffffu); }
    gla_stage_vT(F, P, row0, h, vT);
#pragma unroll
    for (int i = 0; i < 2; ++i) { const int ci = F.tid + 512 * i, v = ci >> 3, ch = ci & 7;
        *(LAS v4u*)((LAS unsigned char*)sTL + v * (GP * 2) + ch * 16) = *(const v4u*)(ST + (size_t)chunk * 8192 + v * 64 + ch * 8); }
    WG_BAR();
    const int tt = w >> 2, vt = w & 3;
    f32x16 oacc;
#pragma unroll
    for (int r = 0; r < 16; ++r) oacc[r] = 0.f;
#pragma unroll
    for (int s = 0; s < 4; ++s) oacc = __builtin_amdgcn_mfma_f32_32x32x16_bf16(ldfrag(qeL, 32 * tt + (lane & 31), 16 * s + 8 * hi), ldfrag(sTL, 32 * vt + (lane & 31), 16 * s + 8 * hi), oacc, 0, 0, 0);
    if (w < 4) { const int at = w >> 1, as = w & 1;
        f32x16 att;
#pragma unroll
        for (int r = 0; r < 16; ++r) att[r] = 0.f;
#pragma unroll
        for (int s = 0; s < 4; ++s) att = __builtin_amdgcn_mfma_f32_32x32x16_bf16(ldfrag(qeL, 32 * at + (lane & 31), 16 * s + 8 * hi), ldfrag(keL, 32 * as + (lane & 31), 16 * s + 8 * hi), att, 0, 0, 0);
#pragma unroll
        for (int r = 0; r < 16; ++r) { const int t = 32 * at + crow(r, hi), sx = 32 * as + (lane & 31); const float v = (sx <= t) ? att[r] : 0.f; attL[t * GP + sx] = (bf16)(cvtpk(v, 0.f) & 0xffffu); } }
    WG_BAR();
#pragma unroll
    for (int s = 0; s < 4; ++s) oacc = __builtin_amdgcn_mfma_f32_32x32x16_bf16(ldfrag(attL, 32 * tt + (lane & 31), 16 * s + 8 * hi), ldfrag(vT, 32 * vt + (lane & 31), 16 * s + 8 * hi), oacc, 0, 0, 0);
#pragma unroll
    for (int r = 0; r < 16; ++r) oL[(32 * tt + crow(r, hi)) * 132 + 32 * vt + (lane & 31)] = oacc[r];
    WG_BAR();
    { const int t = F.tid >> 3, v8 = F.tid & 7;
      float ov[16]; float ss = 0.f;
#pragma unroll
      for (int i = 0; i < 4; ++i) { const f32x4 x = *(const LAS f32x4*)(oL + t * 132 + 16 * v8 + 4 * i); ov[4 * i] = x[0]; ov[4 * i + 1] = x[1]; ov[4 * i + 2] = x[2]; ov[4 * i + 3] = x[3]; ss += (x[0] * x[0] + x[1] * x[1]) + (x[2] * x[2] + x[3] * x[3]); }
      ss += __shfl_xor(ss, 1); ss += __shfl_xor(ss, 2); ss += __shfl_xor(ss, 4);
      const float rstd = 1.0f / sqrtf(ss * (1.0f / 128.0f) + NORM_EPS);
      const bf16* gz = P + (row0 + t) * NPROJ + PC_GZ + h * 128 + 16 * v8; const v4u g0 = *(const v4u*)gz, g1 = *(const v4u*)(gz + 8);
      const float* nw = a.gnw + 16 * v8;
      const unsigned gzw[8] = {g0.x, g0.y, g0.z, g0.w, g1.x, g1.y, g1.z, g1.w}; unsigned ow[8];
#pragma unroll
      for (int i = 0; i < 8; ++i) { const float y0 = ov[2 * i] * rstd * nw[2 * i] * siluf_(bflo(gzw[i])), y1 = ov[2 * i + 1] * rstd * nw[2 * i + 1] * siluf_(bfhi(gzw[i])); ow[i] = cvtpk(y0, y1); }
      bf16* dst = A2 + (row0 + t) * 512 + h * 128 + 16 * v8; *(v4u*)dst = (v4u){ow[0], ow[1], ow[2], ow[3]}; *(v4u*)(dst + 8) = (v4u){ow[4], ow[5], ow[6], ow[7]}; }
    WG_BAR();
}
__device__ __forceinline__ void gla_sample_unit(Frame& F, const Args& a, int su, unsigned char* ws, float* outp) {
    const bf16* P = (const bf16*)(ws + WS_P); const float* GLR = (const float*)(ws + WS_GLR); bf16* A2 = (bf16*)(ws + WS_A2);
    const int db = su >> 2, h = su & 3; const size_t row0 = (size_t)MP + db * 8;
    LAS float* laL = (LAS float*)(F.lds + 0); LAS float* qeL = laL + 512; LAS float* keL = qeL + 512; LAS float* kdL = keL + 512; LAS float* decL = kdL + 512; LAS float* attL = decL + 64;
    LAS float* poL = attL + 64;
    LAS float* oL = poL + 4096;
    const int lane = F.lane, w = F.wave;
    { const int t = w, k = lane; float gp = a.ba[h * 64 + k];
#pragma unroll
      for (int r = 0; r < 16; ++r) gp += GLR[(row0 + t) * 16 + r] * a.wa2[r * 256 + h * 64 + k];
      laL[t * 64 + k] = logsigf_(gp) * (1.0f / 16.0f); }
    WG_BAR();
    { const int t = w, k = lane; float bsum = 0.f, all = 0.f;
#pragma unroll
      for (int i = 0; i < 8; ++i) { const float v = laL[i * 64 + k]; all += v; bsum += (i <= t) ? v : 0.f; }
      const size_t pr = (row0 + t) * NPROJ + h * 64 + k; const float gq = bf2f(P[pr + PC_GQ]), gk = bf2f(P[pr + PC_GK]);
      qeL[t * 64 + k] = gq * 0.125f * __expf(bsum); keL[t * 64 + k] = gk * __expf(-bsum); kdL[t * 64 + k] = gk * __expf(all - bsum);
      if (t == 0) decL[k] = __expf(all); }
    WG_BAR();
    if (F.tid < 64) { const int t = F.tid >> 3, s = F.tid & 7; float acc = 0.f;
        for (int k = 0; k < 64; ++k) acc += qeL[t * 64 + k] * keL[s * 64 + k];
        attL[t * 8 + s] = (s <= t) ? acc : 0.f; }
    const int v = F.tid & 127, kq = F.tid >> 7;
    float vv[8];
#pragma unroll
    for (int s = 0; s < 8; ++s) vv[s] = bf2f(P[(row0 + s) * NPROJ + PC_GV + h * 128 + v]);
    { float po[8];
#pragma unroll
      for (int t = 0; t < 8; ++t) po[t] = 0.f;
      const size_t sbase = ((size_t)(db * 4 + h) * 64) * 128 + v;
#pragma unroll 4
      for (int kk = 0; kk < 16; ++kk) { const int k = 16 * kq + kk; const float s0 = a.sgla[sbase + (size_t)k * 128];
          float ns = decL[k] * s0;
#pragma unroll
          for (int s = 0; s < 8; ++s) ns += kdL[s * 64 + k] * vv[s];
          outp[OFF_GLAS + sbase + (size_t)k * 128] = ns;
#pragma unroll
          for (int t = 0; t < 8; ++t) po[t] += qeL[t * 64 + k] * s0; }
#pragma unroll
      for (int t = 0; t < 8; ++t) poL[(kq * 8 + t) * 128 + v] = po[t]; }
    WG_BAR();
#pragma unroll
    for (int i = 0; i < 2; ++i) { const int t = 2 * kq + i; float o = (poL[(0 * 8 + t) * 128 + v] + poL[(1 * 8 + t) * 128 + v]) + (poL[(2 * 8 + t) * 128 + v] + poL[(3 * 8 + t) * 128 + v]);
#pragma unroll
        for (int s = 0; s < 8; ++s) o += attL[t * 8 + s] * vv[s];
        oL[t * 128 + v] = o; }
    WG_BAR();
    { const int t = w; const float o0 = oL[t * 128 + 2 * lane], o1 = oL[t * 128 + 2 * lane + 1];
      const float ss = wave_sum(o0 * o0 + o1 * o1); const float rstd = 1.0f / sqrtf(ss * (1.0f / 128.0f) + NORM_EPS);
      const unsigned gz = *(const unsigned*)(P + (row0 + t) * NPROJ + PC_GZ + h * 128 + 2 * lane);
      const float y0 = o0 * rstd * a.gnw[2 * lane] * siluf_(bflo(gz)), y1 = o1 * rstd * a.gnw[2 * lane + 1] * siluf_(bfhi(gz));
      *(unsigned*)(A2 + (row0 + t) * 512 + h * 128 + 2 * lane) = cvtpk(y0, y1); }
    WG_BAR();
}
__device__ __forceinline__ void combine_rows(Frame& F, const Args& a, unsigned char* ws, float* outp) {
    const bf16* P = (const bf16*)(ws + WS_P); const bf16* OG = (const bf16*)(ws + WS_OG); const float* LSE = (const float*)(ws + WS_LSE); bf16* A1 = (bf16*)(ws + WS_A1);
    const int gw = F.bid * NWAVES + F.wave, NGW = F.G * NWAVES, lane = F.lane, c0 = 8 * lane, head = lane >> 3;
    for (int row = gw; row < MT; row += NGW) {
        const float l0 = LSE[((size_t)0 * MT + row) * 8 + head], l1 = LSE[((size_t)1 * MT + row) * 8 + head], l2 = LSE[((size_t)2 * MT + row) * 8 + head];
        const float mx = fmaxf(l0, fmaxf(l1, l2));
        float w0 = __builtin_amdgcn_exp2f(l0 - mx), w1 = __builtin_amdgcn_exp2f(l1 - mx), w2 = __builtin_amdgcn_exp2f(l2 - mx);
        const float inv = 1.0f / (w0 + w1 + w2); w0 *= inv; w1 *= inv; w2 *= inv;
        const v4u o0 = *(const v4u*)(OG + ((size_t)0 * MT + row) * 512 + c0), o1 = *(const v4u*)(OG + ((size_t)1 * MT + row) * 512 + c0), o2 = *(const v4u*)(OG + ((size_t)2 * MT + row) * 512 + c0);
        const v4u az = *(const v4u*)(P + (size_t)row * NPROJ + PC_AZ + c0);
        const unsigned a0[4] = {o0.x, o0.y, o0.z, o0.w}, a1[4] = {o1.x, o1.y, o1.z, o1.w}, a2[4] = {o2.x, o2.y, o2.z, o2.w}, zz[4] = {az.x, az.y, az.z, az.w}; unsigned ow[4];
#pragma unroll
        for (int i = 0; i < 4; ++i) { const float y0 = (w0 * bflo(a0[i]) + w1 * bflo(a1[i]) + w2 * bflo(a2[i])) * siluf_(bflo(zz[i])), y1 = (w0 * bfhi(a0[i]) + w1 * bfhi(a1[i]) + w2 * bfhi(a2[i])) * siluf_(bfhi(zz[i])); ow[i] = cvtpk(y0, y1); }
        *(v4u*)(A1 + (size_t)row * 512 + c0) = (v4u){ow[0], ow[1], ow[2], ow[3]};
    }
}
__device__ __forceinline__ void final_norm(Frame& F, const Args& a, unsigned char* ws, float* outp) {
    const float* rowss = (const float*)(ws + WS_ROWSS);
    const int gw = F.bid * NWAVES + F.wave, NGW = F.G * NWAVES, lane = F.lane;
    f32x4 fw[4];
#pragma unroll
    for (int j = 0; j < 4; ++j) fw[j] = *((const f32x4*)a.fnw + lane + 64 * j);
    for (int row = gw; row < MT; row += NGW) {
        float ss = rowss[(size_t)row * 16 + (lane & 15)];
        ss += __shfl_xor(ss, 1); ss += __shfl_xor(ss, 2); ss += __shfl_xor(ss, 4); ss += __shfl_xor(ss, 8);
        const float rstd = 1.0f / sqrtf(ss * (1.0f / 1024.0f) + NORM_EPS);
        f32x4* yr = (f32x4*)(outp + OFF_Y + (size_t)row * 1024) + lane;
#pragma unroll
        for (int j = 0; j < 4; ++j) { const f32x4 v = yr[64 * j]; yr[64 * j] = v * rstd * fw[j]; }
    }
}

__global__ void __launch_bounds__(NWAVES * 64, 2) hybrid_fwd(Args args) {
    extern __shared__ __attribute__((aligned(16))) unsigned char lds[];
    gu32* ctl0 = (gu32*)(args.ws + WS_CTL);
    for (int u = threadIdx.x; u < (LDS_BYTES - LDSCTL_OFF) / 4; u += NWAVES * 64) ((LAS unsigned*)((LAS unsigned char*)lds + LDSCTL_OFF))[u] = 0u;
    __syncthreads();
    XcdBarrier bar = xcd_barrier_post((unsigned*)(ctl0 + CW_BAR), (volatile LAS unsigned*)((LAS unsigned char*)lds + MISC_OFF) + 8);
#define FRESH(A) const Args& A = args; size_t z_ = 0; asm volatile("" : "+s"(z_)); unsigned char* ws = args.ws + z_; float* outp = args.out + z_; (void)A; \
    Frame F; { int t_ = threadIdx.x; asm volatile("" : "+v"(t_)); F.lds = (LAS unsigned char*)lds; F.MISC = (volatile LAS unsigned*)(F.lds + MISC_OFF); F.tid = t_; F.lane = t_ & 63; \
      F.wave = __builtin_amdgcn_readfirstlane(t_ >> 6); F.G = gridDim.x; F.bid = blockIdx.x; F.ctl = (gu32*)(ws + WS_CTL); }

#ifndef SKIP_P0
    { FRESH(A); p0_prologue(F, A, ws, outp); }
#endif
    xcd_barrier(bar);

#ifndef SKIP_P1
    { FRESH(A); pg8::Gemm g{(const pg8::bf16_t*)(ws + WS_XN), (const pg8::bf16_t*)(ws + WS_WIN), MT, NIN, DM}; pg8::StaticOrder S; S.init(MT, NIN, F.G, F.bid);
      EpiProj E{(bf16*)(ws + WS_P), (float*)(ws + WS_GLR), (const float*)(ws + WS_ROPE), (const float*)(ws + WS_ROPE) + 8200 * 8, outp};
      pg8::gemm_phase<EpiProj, pg8::StaticOrder, true, true>(F.lds + RING_OFF, g, S, E); }
#endif
    xcd_barrier(bar);

#ifndef SKIP_P2A
    { FRESH(A); for (int u = F.bid; u < 3072; u += F.G) attn_prompt_unit(F, A, u, ws, outp); }
#endif
#ifndef SKIP_P2B
    { FRESH(A); for (int u = F.bid; u < 1664; u += F.G) attn_sample_unit(F, A, u, ws, outp); }
#endif
#ifndef SKIP_P2C
    { FRESH(A); for (int u = F.bid; u < NCHUNK; u += F.G) gla_g1_unit(F, A, u, ws, outp); }
#endif
#ifndef SKIP_P2D
    { FRESH(A); for (int u = F.bid; u < 512; u += F.G) gla_sample_unit(F, A, u, ws, outp); }
#endif
    xcd_barrier(bar);

#ifndef SKIP_P3
    { FRESH(A); gla_scan(F, A, ws, outp); }
#endif
    xcd_barrier(bar);

#ifndef SKIP_P4
    { FRESH(A); for (int u = F.bid; u < NCHUNK; u += F.G) gla_g3_unit(F, A, u, ws, outp); }
    { FRESH(A); combine_rows(F, A, ws, outp); }
#endif
    xcd_barrier(bar);

#ifndef SKIP_P5
    { FRESH(A); pg8::Gemm g{(const pg8::bf16_t*)(ws + WS_A1), (const pg8::bf16_t*)(ws + WS_WA), MT, DM, 512}; pg8::StaticOrder S; S.init(MT, DM, F.G, F.bid);
      EpiGateA E{(const bf16*)(ws + WS_P), (float*)(ws + WS_T1)};
      pg8::gemm_phase<EpiGateA, pg8::StaticOrder, true, true>(F.lds + RING_OFF, g, S, E); }
    { FRESH(A); pg8::Gemm g{(const pg8::bf16_t*)(ws + WS_A2), (const pg8::bf16_t*)(ws + WS_WB), MT, DM, 512}; pg8::StaticOrder S; S.init(MT, DM, F.G, F.bid);
      EpiGateB E{(const bf16*)(ws + WS_P), (const float*)(ws + WS_T1), (bf16*)(ws + WS_MIX)};
      pg8::gemm_phase<EpiGateB, pg8::StaticOrder, true, true>(F.lds + RING_OFF, g, S, E); }
#endif
    xcd_barrier(bar);

#ifndef SKIP_P6
    { FRESH(A); pg8::Gemm g{(const pg8::bf16_t*)(ws + WS_MIX), (const pg8::bf16_t*)(ws + WS_WO), MT, DM, DM}; pg8::StaticOrder S; S.init(MT, DM, F.G, F.bid);
      EpiResid E{A.xp, A.xs, outp + OFF_Y, (float*)(ws + WS_ROWSS)};
      pg8::gemm_phase<EpiResid, pg8::StaticOrder, true, true>(F.lds + RING_OFF, g, S, E); }
#endif
    xcd_barrier(bar);

#ifndef SKIP_P7
    { FRESH(A); final_norm(F, A, ws, outp); }
#endif
}

extern "C" void kernel_launch(void* const* d_in, const int* in_sizes, int n_in, void* d_out, int out_size, void* d_ws, size_t ws_size, hipStream_t stream) {
    static int grid = 0;
    if (grid == 0) {
        if (n_in != 15 || (size_t)out_size != OUT_TOTAL || ws_size < WS_END) { fprintf(stderr, "kernel_launch: unexpected sizes n_in %d out %d ws %zu\n", n_in, out_size, ws_size); grid = -1; return; }
        int dev = 0, cus = 0, per_cu = 0;
        if (hipGetDevice(&dev) != hipSuccess || hipDeviceGetAttribute(&cus, hipDeviceAttributeMultiprocessorCount, dev) != hipSuccess) { grid = -1; return; }
        if (hipFuncSetAttribute((const void*)hybrid_fwd, hipFuncAttributeMaxDynamicSharedMemorySize, LDS_BYTES) != hipSuccess) { fprintf(stderr, "kernel_launch: hipFuncSetAttribute failed\n"); grid = -1; return; }
        if (hipOccupancyMaxActiveBlocksPerMultiprocessor(&per_cu, (const void*)hybrid_fwd, NWAVES * 64, LDS_BYTES) != hipSuccess || per_cu < 1)
            fprintf(stderr, "kernel_launch: note: occupancy query reports %d workgroups per CU\n", per_cu);
        (void)hipGetLastError();
        grid = cus;
    }
    if (grid < 0) return;
    if (hipMemsetAsync((char*)d_ws + WS_CTL, 0, CTL_ZERO_BYTES, stream) != hipSuccess) return;
    Args a{};
    a.xp = (const float*)d_in[0]; a.xs = (const float*)d_in[1]; a.c128 = (const float*)d_in[2]; a.c512 = (const float*)d_in[3]; a.c2048 = (const float*)d_in[4]; a.sgla = (const float*)d_in[5];
    a.lnw = (const float*)d_in[6]; a.win = (const float*)d_in[7]; a.wa2 = (const float*)d_in[8]; a.ba = (const float*)d_in[9]; a.gnw = (const float*)d_in[10]; a.wao = (const float*)d_in[11];
    a.wgo = (const float*)d_in[12]; a.wout = (const float*)d_in[13]; a.fnw = (const float*)d_in[14];
    a.out = (float*)d_out; a.ws = (unsigned char*)d_ws;
    hipLaunchKernelGGL(hybrid_fwd, dim3(grid), dim3(NWAVES * 64), LDS_BYTES, stream, a);
}
```

```cpp
#include <hip/hip_runtime.h>
#include <cstdio>
#include <cstdint>
namespace pg8 {
#define PG8_LAS __attribute__((address_space(3)))
typedef unsigned short bf16_t;
typedef short bf16x8 __attribute__((ext_vector_type(8)));
typedef float f32x4 __attribute__((ext_vector_type(4)));
typedef unsigned u32x4 __attribute__((ext_vector_type(4)));
constexpr int BM = 256, BK = 64, HALF = 128, HTB = HALF * BK * 2  , STAGE_BYTES = 8 * HTB, NXCD = 8, WGM = 8;

__host__ __device__ __forceinline__ int lds_byte(int r, int c) { const int st = (r >> 4) * 2 + (c >> 5), rr = r & 15, cc = c & 31, ob = rr * 64 + cc * 2; return st * 1024 + (ob ^ (((ob >> 9) & 1) << 5)); }
__host__ __device__ __forceinline__ void stage_rc(int b, int& R, int& C) { const int st = b / 1024, sb = b % 1024, swz = sb ^ (((sb >> 9) & 1) << 5); R = (st >> 1) * 16 + swz / 64; C = (st & 1) * 32 + (swz % 64) / 2; }
__host__ __device__ __forceinline__ int perm32(int rho) { const int n = rho >> 4, i = rho & 15; return 8 * (i >> 2) + 4 * n + (i & 3); }

struct Unit { int pm, pn; };
struct Gemm { const bf16_t* A; const bf16_t* Bt; int M, N, K; };

struct StaticOrder {
    int nM, nN, nwg, G, c;
    __host__ __device__ void init(int M, int N, int G_, int c_) { nM = M / BM; nN = N / BM; nwg = nM * nN; G = G_; c = c_; }
    __host__ __device__ bool next(int i, Unit& u) const {
        const long L = (long)i * G + c; if (L >= nwg) return false;
        int wgid = (int)L; { const int q = nwg / NXCD, r = nwg % NXCD, xcd = wgid % NXCD, off = wgid / NXCD; wgid = (xcd < r ? xcd * (q + 1) : r * (q + 1) + (xcd - r) * q) + off; }
        const int nig = WGM * nN, gid = wgid / nig, fm = gid * WGM, gsz = (nM - fm) < WGM ? (nM - fm) : WGM;
        u.pm = fm + ((wgid % nig) % gsz); u.pn = (wgid % nig) / gsz; return true;
    }
    __device__ __forceinline__ void a_ready(const Unit&) const {}
    __device__ __forceinline__ void done(const Unit&) const {}
};

__device__ __forceinline__ unsigned cvt_pk_bf16(float lo, float hi) { unsigned r; asm volatile("v_cvt_pk_bf16_f32 %0, %1, %2" : "=v"(r) : "v"(lo), "v"(hi)); return r; }
typedef float f32x2 __attribute__((ext_vector_type(2)));
template <class Epi, class Sched, bool ALIGN_EPI = false, bool SP2 = false>
__device__ __forceinline__ void gemm_phase(PG8_LAS unsigned char* lds, const Gemm g, const Sched& S, const Epi& E, int tid_in) {
    int tid_ = tid_in; asm volatile("" : "+v"(tid_));
    const int tid = tid_, wid = __builtin_amdgcn_readfirstlane(tid >> 6), lane = tid & 63, wr = wid >> 2, wc = wid & 3, fr = lane & 15, fq = lane >> 4;
    const int K = g.K, nt = K / BK;
    unsigned voffA[2], voffB[2];
#pragma unroll
    for (int i = 0; i < 2; ++i) { int R, C; stage_rc(tid * 16 + i * 8192, R, C); const int Rb = Epi::PERM ? ((R & ~31) + perm32(R & 31)) : R;
        voffA[i] = (unsigned)(R * K + C) * 2u; voffB[i] = (unsigned)(Rb * K + C) * 2u; }
    const size_t kstep = (size_t)(BK * 2);
    const size_t hstep = (size_t)HALF * K * 2;
    const size_t tstep = 2 * hstep;
    const unsigned ldsw = (unsigned)wid * 1024u;
    const int aoff = lds_byte(wr * 64 + fr, fq * 8), boff = lds_byte(wc * 32 + fr, fq * 8);
#define PG8_SA(b, h) (((b) * 2 + (h)) * HTB)
#define PG8_SB(b, h) ((4 + (b) * 2 + (h)) * HTB)
#define PG8_STAGE(bufoff, gbase, voff) do { _Pragma("unroll") for (int _i = 0; _i < 2; ++_i) \
        __builtin_amdgcn_global_load_lds((const unsigned*)((const char*)(gbase) + (voff)[_i]), (PG8_LAS unsigned*)(lds + (bufoff) + ldsw + _i * 8192), 16, 0, 0); } while (0)
#define PG8_LDA(dst, b, h) do { _Pragma("unroll") for (int m = 0; m < 4; ++m) _Pragma("unroll") for (int k = 0; k < 2; ++k) dst[m][k] = *(const PG8_LAS bf16x8*)(lds + PG8_SA(b, h) + aoff + m * 2048 + k * 1024); } while (0)
#define PG8_LDB(dst, b, h) do { _Pragma("unroll") for (int n = 0; n < 2; ++n) _Pragma("unroll") for (int k = 0; k < 2; ++k) dst[n][k] = *(const PG8_LAS bf16x8*)(lds + PG8_SB(b, h) + boff + n * 2048 + k * 1024); } while (0)
#define PG8_MMA(ai, bj, At, Bt) do { __builtin_amdgcn_s_setprio(1); _Pragma("unroll") for (int m = 0; m < 4; ++m) _Pragma("unroll") for (int n = 0; n < 2; ++n) _Pragma("unroll") for (int k = 0; k < 2; ++k) \
        acc[ai][bj][m][n] = __builtin_amdgcn_mfma_f32_16x16x32_bf16(Bt[n][k], At[m][k], acc[ai][bj][m][n], 0, 0, 0); __builtin_amdgcn_s_setprio(0); } while (0)
#define PG8_WAIT_V(n) asm volatile("s_waitcnt vmcnt(" #n ")" ::: "memory")
#define PG8_WAIT_L(n) asm volatile("s_waitcnt lgkmcnt(" #n ")" ::: "memory")
#define PG8_BAR __builtin_amdgcn_s_barrier()
#define PG8_SCHED __builtin_amdgcn_sched_barrier(0)
    Unit cur, nxt; int ui = 0;
    if (!S.next(0, cur)) return;
    f32x4 acc[2][2][4][2];
#pragma unroll
    for (int a = 0; a < 2; ++a)
#pragma unroll
        for (int b = 0; b < 2; ++b)
#pragma unroll
            for (int m = 0; m < 4; ++m)
#pragma unroll
                for (int n = 0; n < 2; ++n) acc[a][b][m][n] = (f32x4){0.f, 0.f, 0.f, 0.f};
    bf16x8 At[4][2], B0[2][2], B1[2][2];
    const char* cA = (const char*)g.A + (size_t)cur.pm * tstep; const char* cB = (const char*)g.Bt + (size_t)cur.pn * tstep;
    S.a_ready(cur);
    if constexpr (SP2) {
        PG8_STAGE(PG8_SB(0, 0), cB, voffB); PG8_STAGE(PG8_SB(0, 1), cB + hstep, voffB); PG8_STAGE(PG8_SA(0, 0), cA, voffA); PG8_STAGE(PG8_SA(0, 1), cA + hstep, voffA);
        if (wr == 1) PG8_BAR;
        PG8_WAIT_V(2); PG8_BAR;
        PG8_STAGE(PG8_SB(1, 0), cB + kstep, voffB); PG8_STAGE(PG8_SA(1, 0), cA + kstep, voffA); PG8_STAGE(PG8_SB(1, 1), cB + hstep + kstep, voffB);
        PG8_WAIT_V(6); PG8_BAR;
    } else {
        PG8_STAGE(PG8_SB(0, 0), cB, voffB); PG8_STAGE(PG8_SA(0, 0), cA, voffA); PG8_STAGE(PG8_SB(0, 1), cB + hstep, voffB); PG8_STAGE(PG8_SA(0, 1), cA + hstep, voffA);
        if (wr == 1) PG8_BAR;
        PG8_WAIT_V(4); PG8_BAR;
        PG8_STAGE(PG8_SB(1, 0), cB + kstep, voffB); PG8_STAGE(PG8_SA(1, 0), cA + kstep, voffA); PG8_STAGE(PG8_SB(1, 1), cB + hstep + kstep, voffB);
        PG8_WAIT_V(6); PG8_BAR;
    }
    for (;;) {
        const bool has_next = S.next(ui + 1, nxt);
        const char* nA = has_next ? (const char*)g.A + (size_t)nxt.pm * tstep : cA; const char* nB = has_next ? (const char*)g.Bt + (size_t)nxt.pn * tstep : cB;
        for (int t = 0; t < nt; t += 2) {
            const bool last = (t == nt - 2);
            const char* a1 = cA + (size_t)(t + 1) * kstep;
            const char* a2 = last ? nA : cA + (size_t)(t + 2) * kstep; const char* b2 = last ? nB : cB + (size_t)(t + 2) * kstep;
            const char* a3 = a2 + kstep; const char* b3 = b2 + kstep;
            if (last && has_next) S.a_ready(nxt);
            if constexpr (SP2) {
            PG8_LDB(B0, 0, 0); PG8_LDB(B1, 0, 1); PG8_SCHED; PG8_LDA(At, 0, 0); PG8_STAGE(PG8_SA(1, 1), a1 + hstep, voffA);
            PG8_WAIT_V(8); PG8_WAIT_L(0); PG8_BAR; PG8_MMA(0, 0, At, B0); PG8_MMA(0, 1, At, B1); PG8_BAR; PG8_SCHED;
            PG8_LDA(At, 0, 1); PG8_STAGE(PG8_SB(0, 0), b2, voffB); PG8_STAGE(PG8_SB(0, 1), b2 + hstep, voffB); PG8_STAGE(PG8_SA(0, 0), a2, voffA);
            PG8_WAIT_V(8); PG8_WAIT_L(0); PG8_BAR; PG8_MMA(1, 0, At, B0); PG8_MMA(1, 1, At, B1); PG8_BAR; PG8_SCHED;
            PG8_LDB(B0, 1, 0); PG8_LDB(B1, 1, 1); PG8_SCHED; PG8_LDA(At, 1, 0); PG8_STAGE(PG8_SA(0, 1), a2 + hstep, voffA);
            PG8_WAIT_V(8); PG8_WAIT_L(0); PG8_BAR; PG8_MMA(0, 0, At, B0); PG8_MMA(0, 1, At, B1); PG8_BAR; PG8_SCHED;
            PG8_LDA(At, 1, 1); PG8_STAGE(PG8_SB(1, 0), b3, voffB); PG8_STAGE(PG8_SB(1, 1), b3 + hstep, voffB); PG8_STAGE(PG8_SA(1, 0), a3, voffA);
            PG8_WAIT_V(8); PG8_WAIT_L(0); PG8_BAR; PG8_MMA(1, 0, At, B0); PG8_MMA(1, 1, At, B1); PG8_BAR; PG8_SCHED;
            } else {
            PG8_LDB(B0, 0, 0); PG8_SCHED; PG8_LDA(At, 0, 0); PG8_STAGE(PG8_SA(1, 1), a1 + hstep, voffA);
            PG8_WAIT_L(8); PG8_BAR; PG8_WAIT_L(0); PG8_MMA(0, 0, At, B0); PG8_BAR; PG8_SCHED;
            PG8_LDB(B1, 0, 1); PG8_STAGE(PG8_SB(0, 0), b2, voffB);
            PG8_BAR; PG8_WAIT_L(0); PG8_MMA(0, 1, At, B1); PG8_BAR;
            PG8_LDA(At, 0, 1); PG8_STAGE(PG8_SA(0, 0), a2, voffA);
            PG8_BAR; PG8_WAIT_L(0); PG8_MMA(1, 0, At, B0); PG8_BAR; PG8_SCHED;
            PG8_STAGE(PG8_SB(0, 1), b2 + hstep, voffB);
            PG8_WAIT_V(6); PG8_BAR; PG8_MMA(1, 1, At, B1); PG8_BAR;
            PG8_LDB(B0, 1, 0); PG8_SCHED; PG8_LDA(At, 1, 0); PG8_STAGE(PG8_SA(0, 1), a2 + hstep, voffA);
            PG8_WAIT_L(8); PG8_BAR; PG8_WAIT_L(0); PG8_MMA(0, 0, At, B0); PG8_BAR; PG8_SCHED;
            PG8_LDB(B1, 1, 1); PG8_STAGE(PG8_SB(1, 0), b3, voffB);
            PG8_BAR; PG8_WAIT_L(0); PG8_MMA(0, 1, At, B1); PG8_BAR;
            PG8_LDA(At, 1, 1); PG8_STAGE(PG8_SA(1, 0), a3, voffA);
            PG8_BAR; PG8_WAIT_L(0); PG8_MMA(1, 0, At, B0); PG8_BAR; PG8_SCHED;
            PG8_STAGE(PG8_SB(1, 1), b3 + hstep, voffB);
            PG8_WAIT_V(6); PG8_BAR; PG8_MMA(1, 1, At, B1); PG8_BAR;
            }
        }
        if constexpr (ALIGN_EPI) { if (wr == 0) PG8_BAR; }
        if constexpr (!Epi::AFTER_DRAIN) { E(acc, cur, wr, wc, fr, fq); S.done(cur); }
        if (!has_next) break;
#pragma unroll
        for (int a = 0; a < 2; ++a)
#pragma unroll
            for (int b = 0; b < 2; ++b)
#pragma unroll
                for (int m = 0; m < 4; ++m)
#pragma unroll
                    for (int n = 0; n < 2; ++n) acc[a][b][m][n] = (f32x4){0.f, 0.f, 0.f, 0.f};
        cur = nxt; cA = nA; cB = nB; ++ui;
        if constexpr (ALIGN_EPI) { if (wr == 1) PG8_BAR; }
    }
    PG8_WAIT_V(0);
    if constexpr (!ALIGN_EPI) { if (wr == 0) PG8_BAR; }
    PG8_BAR;
    if constexpr (Epi::AFTER_DRAIN) { E.fused(acc, cur, wr, wc, fr, fq, lds, wid, lane); S.done(cur); }
#undef PG8_SA
#undef PG8_SB
#undef PG8_STAGE
#undef PG8_LDA
#undef PG8_LDB
#undef PG8_MMA
#undef PG8_WAIT_V
#undef PG8_WAIT_L
#undef PG8_BAR
#undef PG8_SCHED
}
}
#define GAS __attribute__((address_space(1)))
#define LAS __attribute__((address_space(3)))
typedef unsigned short bf16;
typedef unsigned v4u __attribute__((ext_vector_type(4)));
typedef float f32x4 __attribute__((ext_vector_type(4)));
typedef short bf16x8 __attribute__((ext_vector_type(8)));
typedef GAS unsigned gu32;
typedef GAS unsigned long long gu64;
#define RLX_AGENT __ATOMIC_RELAXED, __HIP_MEMORY_SCOPE_AGENT
#define LDS_WAIT() asm volatile("s_waitcnt lgkmcnt(0)" ::: "memory")
#define VM_WAIT() asm volatile("s_waitcnt vmcnt(0)" ::: "memory")
__device__ __forceinline__ unsigned long long rt() { return __builtin_amdgcn_s_memrealtime(); }
__device__ __forceinline__ unsigned f2bf(float f) { unsigned u = __builtin_bit_cast(unsigned, f); return (u + 0x7fffu + ((u >> 16) & 1u)) >> 16; }
__device__ __forceinline__ unsigned pk2(float lo, float hi) { return f2bf(lo) | (f2bf(hi) << 16); }

#define XB_TMO      128
#define XB_XCNT(j)  (256  + 64 * (j))
#define XB_XSUB(j)  (1280 + 64 * (j))
#define XB_XGEN(j)  (2304 + 64 * (j))
#define XB_TOP      3328
#define XB_TOPGEN   3392
#define XCD_BAR_WORDS 3456
#define XB_SPIN_CAP (1u << 18)

__device__ __forceinline__ unsigned xb_ld(unsigned* p)              { return __hip_atomic_load(p, __ATOMIC_RELAXED, __HIP_MEMORY_SCOPE_AGENT); }
__device__ __forceinline__ unsigned xb_add(unsigned* p, unsigned v) { return __hip_atomic_fetch_add(p, v, __ATOMIC_RELAXED, __HIP_MEMORY_SCOPE_AGENT); }
__device__ __forceinline__ unsigned xb_xcc_id() { return (unsigned)__builtin_amdgcn_s_getreg((3 << 11) | 20) & 0xFu; }
#define XB_SPIN(cond, bar) do { unsigned _sp = 0; while (cond) { __builtin_amdgcn_s_sleep(1); \
    if ((++_sp & 255u) == 0u) { if (xb_ld(&(bar)[XB_TMO])) break; if (_sp > XB_SPIN_CAP) { atomicAdd(&(bar)[XB_TMO], 1u); break; } } } } while (0)

struct XcdBarrier {
    unsigned* bar; unsigned x;
    volatile LAS unsigned* st;
};

__device__ __forceinline__ XcdBarrier xcd_barrier_post(unsigned* bar, volatile LAS unsigned* st) {
    XcdBarrier b; b.bar = bar; b.x = xb_xcc_id(); b.st = st;
    if (threadIdx.x == 0) (void)xb_add(&bar[XB_XCNT(b.x)], 1u);
    return b;
}
__device__ __forceinline__ void xcd_barrier_complete(unsigned* bar, unsigned x, unsigned& nloc, unsigned& nx) {
    const unsigned G = gridDim.x * gridDim.y * gridDim.z;
    unsigned sum, cnt, mine, sp = 0u;
    for (;;) {
        sum = 0u; cnt = 0u; mine = 0u;
#pragma unroll
        for (unsigned j = 0; j < 16; ++j) { const unsigned c = xb_ld(&bar[XB_XCNT(j)]); sum += c; cnt += (c > 0u) ? 1u : 0u; mine = (j == x) ? c : mine; }
        if (sum == G) break;
        __builtin_amdgcn_s_sleep(1);
        if ((++sp & 255u) == 0u) { if (xb_ld(&bar[XB_TMO])) break; if (sp > XB_SPIN_CAP) { atomicAdd(&bar[XB_TMO], 1u); break; } }
    }
    nloc = mine > 0u ? mine : 1u; nx = cnt > 0u ? cnt : 1u;
}

__device__ __forceinline__ void xcd_barrier(const XcdBarrier& b) {
    asm volatile("s_waitcnt vmcnt(0)" ::: "memory");
    __syncthreads();
    if (threadIdx.x == 0) {
        unsigned* bar = b.bar;
        __builtin_amdgcn_s_waitcnt(0);
        unsigned nloc = b.st[0], nx = b.st[1];
        if (nloc == 0u) { xcd_barrier_complete(bar, b.x, nloc, nx); b.st[0] = nloc; b.st[1] = nx; }
        const unsigned old = xb_add(&bar[XB_XSUB(b.x)], 1u);
        const unsigned gen = old / nloc;
        if (old + 1u == (gen + 1u) * nloc) {
            __builtin_amdgcn_fence(__ATOMIC_RELEASE, "agent");
            asm volatile("s_waitcnt vmcnt(0)" ::: "memory");
            const unsigned og = xb_add(&bar[XB_TOP], 1u);
            const unsigned tg = og / nx;
            if (og + 1u == (tg + 1u) * nx) xb_add(&bar[XB_TOPGEN], 1u);
            else XB_SPIN(xb_ld(&bar[XB_TOPGEN]) == tg, bar);
            __builtin_amdgcn_fence(__ATOMIC_ACQUIRE, "agent");
            xb_add(&bar[XB_XGEN(b.x)], 1u);
            asm volatile("s_waitcnt vmcnt(0)" ::: "memory");
        } else {
            XB_SPIN(xb_ld(&bar[XB_XGEN(b.x)]) == gen, bar);
            __builtin_amdgcn_fence(__ATOMIC_ACQUIRE, "agent");
            asm volatile("s_waitcnt vmcnt(0)" ::: "memory");
        }
    }
    __syncthreads();
}

typedef float f32x16 __attribute__((ext_vector_type(16)));
typedef short v4i16_t __attribute__((ext_vector_type(4)));
typedef float f32x2_t __attribute__((ext_vector_type(2)));
typedef __bf16 bf16x2_t __attribute__((ext_vector_type(2)));

constexpr int DM = 1024, SEQ = 8192, NBATCH = 4, DBATCH = 128, TDEC = 8;
constexpr int MP = NBATCH * SEQ;
constexpr int MS = DBATCH * TDEC;
constexpr int MT = MP + MS;
constexpr int NPROJ = 8704;
constexpr int NIN = 8960;
constexpr int PC_Q = 0, PC_K = 1536, PC_V = 3072, PC_AZ = 4608, PC_GQ = 5120, PC_GK = 5376, PC_GV = 5632, PC_GZ = 6144, PC_MGA = 6656, PC_MGB = 7680;
constexpr float NORM_EPS = 1e-6f;
constexpr float QSCALE = 0.18033688011112042f;
constexpr int NCHUNK = 2048;

constexpr size_t OFF_Y = 0;
constexpr size_t OFF_KVP0 = 34603008, OFF_KVP1 = 35127296, OFF_KVP2 = 37224448, OFF_GLAP = 45613056;
constexpr size_t OFF_KVS0 = 45744128, OFF_KVS1 = 46792704, OFF_KVS2 = 47841280, OFF_GLAS = 48889856, OUT_TOTAL = 53084160;

constexpr size_t MiB = 1u << 20;
constexpr size_t WS_CTL = 0, CTL_ZERO_BYTES = 1 * MiB;
constexpr size_t WS_ROPE = 1 * MiB;
constexpr size_t WS_ROWSS = 2 * MiB;
constexpr size_t WS_WIN = 8 * MiB;
constexpr size_t WS_WA = 26 * MiB, WS_WB = 27 * MiB, WS_WO = 28 * MiB;
constexpr size_t WS_XN = 32 * MiB;
constexpr size_t WS_P = 128 * MiB;
constexpr size_t WS_GLR = 704 * MiB;
constexpr size_t WS_OG = 768 * MiB;
constexpr size_t WS_LSE = 896 * MiB;
constexpr size_t WS_UT = 1024 * MiB;
constexpr size_t WS_DC = 1100 * MiB;
constexpr size_t WS_ST = 1152 * MiB;
constexpr size_t WS_A1 = 1216 * MiB, WS_A2 = 1280 * MiB;
constexpr size_t WS_T1 = 1408 * MiB;
constexpr size_t WS_MIX = 1600 * MiB;
constexpr size_t WS_END = 1700 * MiB;
constexpr int CW_BAR = 4096;

constexpr int RING_OFF = 0, RING_BYTES = 131072;
constexpr int LDSCTL_OFF = RING_BYTES, MISC_OFF = LDSCTL_OFF + 320;
constexpr int LDS_BYTES = 147456;
constexpr int NWAVES = 8;

__device__ __forceinline__ unsigned cvtpk(float lo, float hi) { f32x2_t v = {lo, hi}; bf16x2_t b = __builtin_convertvector(v, bf16x2_t); return __builtin_bit_cast(unsigned, b); }
__device__ __forceinline__ float bf2f(unsigned short u) { return __builtin_bit_cast(float, (unsigned)u << 16); }
__device__ __forceinline__ float bflo(unsigned u) { return __builtin_bit_cast(float, u << 16); }
__device__ __forceinline__ float bfhi(unsigned u) { return __builtin_bit_cast(float, u & 0xffff0000u); }
__device__ __forceinline__ float sigmoidf_(float x) { return __builtin_amdgcn_rcpf(1.0f + __builtin_amdgcn_exp2f(-1.4426950408889634f * x)); }
__device__ __forceinline__ float siluf_(float x) { return x * __builtin_amdgcn_rcpf(1.0f + __builtin_amdgcn_exp2f(-1.4426950408889634f * x)); }
__device__ __forceinline__ float logsigf_(float x) { return fminf(x, 0.f) - log1pf(__expf(-fabsf(x))); }
__device__ __forceinline__ int crow(int r, int hi) { return (r & 3) + 8 * (r >> 2) + 4 * hi; }
__device__ __forceinline__ float wave_sum(float v) {
#pragma unroll
    for (int o = 1; o < 64; o <<= 1) v += __shfl_xor(v, o);
    return v;
}
#define WG_BAR() do { asm volatile("s_waitcnt vmcnt(0) lgkmcnt(0)" ::: "memory"); __builtin_amdgcn_s_barrier(); asm volatile("" ::: "memory"); } while (0)

struct Args {
    const float* xp; const float* xs; const float* c128; const float* c512; const float* c2048; const float* sgla;
    const float* lnw; const float* win; const float* wa2; const float* ba; const float* gnw; const float* wao; const float* wgo; const float* wout; const float* fnw;
    float* out; unsigned char* ws;
};

struct EpiProj {
    static constexpr bool PERM = true, AFTER_DRAIN = false;
    bf16* P; float* glr; const float* rc; const float* rs; float* out;
    __device__ __forceinline__ void operator()(const pg8::f32x4 (&acc)[2][2][4][2], const pg8::Unit& u, int wr, int wc, int fr, int fq) const {
        const int pn = u.pn; const int row0 = u.pm * 256 + wr * 64 + fr;
        const int kind = pn < 6 ? 0 : (pn < 12 ? 1 : (pn < 18 ? 2 : 3));
        const bool rope = (kind <= 1) && ((wc & 1) == 0);
        const int colb = pn * 256 + wc * 32 + 8 * fq;
        const int g = (kind == 1) ? ((pn - 6) >> 1) : ((pn - 12) >> 1);
        const int W = 128 << (2 * g);
        const size_t offp = (g == 0) ? OFF_KVP0 : (g == 1 ? OFF_KVP1 : OFF_KVP2);
        const size_t offs = (g == 0) ? OFF_KVS0 : (g == 1 ? OFF_KVS1 : OFF_KVS2);
#pragma unroll
        for (int ai = 0; ai < 2; ++ai)
#pragma unroll
            for (int m = 0; m < 4; ++m) {
                const int row = row0 + ai * 128 + m * 16;
                f32x4 cA = {1.f, 1.f, 1.f, 1.f}, cB = cA, sA = {0.f, 0.f, 0.f, 0.f}, sB = sA;
                if (rope) { const int pos = row < MP ? (row & (SEQ - 1)) : SEQ + ((row - MP) & 7);
                    cA = *(const f32x4*)(rc + pos * 8); cB = *(const f32x4*)(rc + pos * 8 + 4); sA = *(const f32x4*)(rs + pos * 8); sB = *(const f32x4*)(rs + pos * 8 + 4); }
#pragma unroll
                for (int bj = 0; bj < 2; ++bj) {
                    f32x4 v0 = acc[ai][bj][m][0], v1 = acc[ai][bj][m][1];
                    if (rope) {
                        f32x4 p0, p1;
#pragma unroll
                        for (int e = 0; e < 4; ++e) { p0[e] = __shfl_xor(v0[e], 16); p1[e] = __shfl_xor(v1[e], 16); }
                        if (fq == 0) { v0 = v0 * cA - p0 * sA; v1 = v1 * cB - p1 * sB; }
                        else if (fq == 1) { v0 = v0 * cA + p0 * sA; v1 = v1 * cB + p1 * sB; }
                    }
                    if (kind == 1 || kind == 2) {
                        const int cg = (pn & 1) * 256 + bj * 128 + wc * 32 + 8 * fq; const int kvsel = kind - 1;
                        if (row < MP) { const int b = row >> 13, t = row & (SEQ - 1);
                            if (t >= SEQ - W) { float* dst = out + offp + ((size_t)(b * W + (t - (SEQ - W))) * 2 + kvsel) * 512 + cg; *(f32x4*)dst = v0; *(f32x4*)(dst + 4) = v1; } }
                        else { float* dst = out + offs + (size_t)(row - MP) * 1024 + kvsel * 512 + cg; *(f32x4*)dst = v0; *(f32x4*)(dst + 4) = v1; }
                    }
                    if (kind == 0) { v0 = v0 * QSCALE; v1 = v1 * QSCALE; }
                    v4u w; w.x = cvtpk(v0[0], v0[1]); w.y = cvtpk(v0[2], v0[3]); w.z = cvtpk(v1[0], v1[1]); w.w = cvtpk(v1[2], v1[3]);
                    *(v4u*)(P + (size_t)row * NPROJ + colb + bj * 128) = w;
                }
            }
    }
};
struct EpiGateA {
    static constexpr bool PERM = true, AFTER_DRAIN = false;
    const bf16* P; bf16* MIX;
    __device__ __forceinline__ void operator()(const pg8::f32x4 (&acc)[2][2][4][2], const pg8::Unit& u, int wr, int wc, int fr, int fq) const {
        const int row0 = u.pm * 256 + wr * 64 + fr, colb = u.pn * 256 + wc * 32 + 8 * fq;
#pragma unroll
        for (int ai = 0; ai < 2; ++ai)
#pragma unroll
            for (int m = 0; m < 4; ++m) { const int row = row0 + ai * 128 + m * 16;
#pragma unroll
                for (int bj = 0; bj < 2; ++bj) { const int col = colb + bj * 128;
                    const v4u gw = *(const v4u*)(P + (size_t)row * NPROJ + PC_MGA + col);
                    f32x4 v0 = acc[ai][bj][m][0], v1 = acc[ai][bj][m][1];
                    v0[0] *= sigmoidf_(bflo(gw.x)); v0[1] *= sigmoidf_(bfhi(gw.x)); v0[2] *= sigmoidf_(bflo(gw.y)); v0[3] *= sigmoidf_(bfhi(gw.y));
                    v1[0] *= sigmoidf_(bflo(gw.z)); v1[1] *= sigmoidf_(bfhi(gw.z)); v1[2] *= sigmoidf_(bflo(gw.w)); v1[3] *= sigmoidf_(bfhi(gw.w));
                    v4u w; w.x = cvtpk(v0[0], v0[1]); w.y = cvtpk(v0[2], v0[3]); w.z = cvtpk(v1[0], v1[1]); w.w = cvtpk(v1[2], v1[3]);
                    *(v4u*)(MIX + (size_t)row * 1024 + col) = w; } }
    }
};
struct EpiGateB {
    static constexpr bool PERM = true, AFTER_DRAIN = false;
    const bf16* P; bf16* MIX;
    __device__ __forceinline__ void operator()(const pg8::f32x4 (&acc)[2][2][4][2], const pg8::Unit& u, int wr, int wc, int fr, int fq) const {
        const int row0 = u.pm * 256 + wr * 64 + fr, colb = u.pn * 256 + wc * 32 + 8 * fq;
#pragma unroll
        for (int ai = 0; ai < 2; ++ai)
#pragma unroll
            for (int m = 0; m < 4; ++m) { const int row = row0 + ai * 128 + m * 16;
#pragma unroll
                for (int bj = 0; bj < 2; ++bj) { const int col = colb + bj * 128;
                    const v4u gw = *(const v4u*)(P + (size_t)row * NPROJ + PC_MGB + col);
                    const v4u t = *(const v4u*)(MIX + (size_t)row * 1024 + col);
                    f32x4 v0 = acc[ai][bj][m][0], v1 = acc[ai][bj][m][1];
                    v0[0] = bflo(t.x) + v0[0] * sigmoidf_(bflo(gw.x)); v0[1] = bfhi(t.x) + v0[1] * sigmoidf_(bfhi(gw.x)); v0[2] = bflo(t.y) + v0[2] * sigmoidf_(bflo(gw.y)); v0[3] = bfhi(t.y) + v0[3] * sigmoidf_(bfhi(gw.y));
                    v1[0] = bflo(t.z) + v1[0] * sigmoidf_(bflo(gw.z)); v1[1] = bfhi(t.z) + v1[1] * sigmoidf_(bfhi(gw.z)); v1[2] = bflo(t.w) + v1[2] * sigmoidf_(bflo(gw.w)); v1[3] = bfhi(t.w) + v1[3] * sigmoidf_(bfhi(gw.w));
                    v4u w; w.x = cvtpk(v0[0], v0[1]); w.y = cvtpk(v0[2], v0[3]); w.z = cvtpk(v1[0], v1[1]); w.w = cvtpk(v1[2], v1[3]);
                    *(v4u*)(MIX + (size_t)row * 1024 + col) = w; } }
    }
};
struct EpiResid {
    static constexpr bool PERM = false, AFTER_DRAIN = false;
    const float* xp; const float* xs; float* out; float* rowss;
    __device__ __forceinline__ void operator()(const pg8::f32x4 (&acc)[2][2][4][2], const pg8::Unit& u, int wr, int wc, int fr, int fq) const {
        const int row0 = u.pm * 256 + wr * 64 + fr, colb = u.pn * 256 + wc * 32 + 4 * fq;
#pragma unroll
        for (int ai = 0; ai < 2; ++ai)
#pragma unroll
            for (int m = 0; m < 4; ++m) { const int row = row0 + ai * 128 + m * 16;
                const float* xr = row < MP ? xp + (size_t)row * 1024 : xs + (size_t)(row - MP) * 1024;
                float ss = 0.f;
#pragma unroll
                for (int bj = 0; bj < 2; ++bj)
#pragma unroll
                    for (int n = 0; n < 2; ++n) { const int col = colb + bj * 128 + n * 16;
                        const f32x4 o = *(const f32x4*)(xr + col) + acc[ai][bj][m][n];
                        *(f32x4*)(out + (size_t)row * 1024 + col) = o;
                        ss += (o[0] * o[0] + o[1] * o[1]) + (o[2] * o[2] + o[3] * o[3]); }
                ss += __shfl_xor(ss, 16); ss += __shfl_xor(ss, 32);
                if (fq == 0) rowss[(size_t)row * 16 + u.pn * 4 + wc] = ss; }
    }
};

struct Frame {
    LAS unsigned char* lds; volatile LAS unsigned* MISC; gu32* ctl;
    int tid, lane, wave, G, bid;
};

__device__ __forceinline__ void p0_tr_item(const float* W, int ldw, int K, bf16* WT, int r0, int c0, int nvalid, int k0, LAS float* scr, int lane) {
    const int j32 = lane & 31;
#pragma unroll 8
    for (int i = 0; i < 32; ++i) { const int kk = 2 * i + (lane >> 5); scr[kk * 33 + j32] = (j32 < nvalid) ? W[(size_t)(k0 + kk) * ldw + c0 + j32] : 0.f; }
    LDS_WAIT(); asm volatile("" ::: "memory");
    const int c = lane & 7;
#pragma unroll
    for (int j = 0; j < 4; ++j) { const int n = (lane >> 3) + 8 * j; const LAS float* s = scr + (8 * c) * 33 + n;
        v4u o; o.x = pk2(s[0 * 33], s[1 * 33]); o.y = pk2(s[2 * 33], s[3 * 33]); o.z = pk2(s[4 * 33], s[5 * 33]); o.w = pk2(s[6 * 33], s[7 * 33]);
        *(v4u*)(WT + (size_t)(r0 + n) * K + k0 + 8 * c) = o; }
    LDS_WAIT(); asm volatile("" ::: "memory");
}
__device__ __forceinline__ void sincos_acc(double a, float& s, float& c) {
    const double k = rint(a * 0.15915494309189533577); const double r = a - k * 6.283185307179586476925;
    const double r2 = r * r;
    double cs = 0.0, sn = 0.0, tc = 1.0, ts = r;
#pragma unroll
    for (int n = 0; n < 15; ++n) { cs += tc; sn += ts; tc = -tc * r2 / (double)((2 * n + 1) * (2 * n + 2)); ts = -ts * r2 / (double)((2 * n + 2) * (2 * n + 3)); }
    s = (float)sn; c = (float)cs;
}
__device__ __forceinline__ void p0_prologue(Frame& F, const Args& a, unsigned char* ws, float* outp) {
    LAS float* scr = (LAS float*)(F.lds + RING_OFF + F.wave * 16384);
    const int gw = F.bid * NWAVES + F.wave, NGW = F.G * NWAVES;
    bf16* Win = (bf16*)(ws + WS_WIN); bf16* Wa = (bf16*)(ws + WS_WA); bf16* Wb = (bf16*)(ws + WS_WB); bf16* Wo = (bf16*)(ws + WS_WO);
    constexpr int I_IN = 16 * 280, I_A = 8 * 32, I_B = 8 * 32, I_O = 16 * 32, NITEMS = I_IN + I_A + I_B + I_O;
    for (int it = gw; it < NITEMS; it += NGW) {
        int r = it;
        if (r < I_IN) { const int kb = r / 280, nb = r % 280, r0 = 32 * nb; int c0, nv;
            if (r0 < 6656) { c0 = r0; nv = 32; } else if (r0 < 8704) { c0 = r0 + 16; nv = 32; } else if (r0 == 8704) { c0 = 6656; nv = 16; } else { c0 = 0; nv = 0; }
            p0_tr_item(a.win, 8720, 1024, Win, r0, c0, nv, 64 * kb, scr, F.lane); continue; }
        r -= I_IN;
        if (r < I_A) { p0_tr_item(a.wao, 1024, 512, Wa, 32 * (r % 32), 32 * (r % 32), 32, 64 * (r / 32), scr, F.lane); continue; }
        r -= I_A;
        if (r < I_B) { p0_tr_item(a.wgo, 1024, 512, Wb, 32 * (r % 32), 32 * (r % 32), 32, 64 * (r / 32), scr, F.lane); continue; }
        r -= I_B;
        p0_tr_item(a.wout, 1024, 1024, Wo, 32 * (r % 32), 32 * (r % 32), 32, 64 * (r / 32), scr, F.lane);
    }
    bf16* XN = (bf16*)(ws + WS_XN);
    f32x4 lw[4];
#pragma unroll
    for (int j = 0; j < 4; ++j) lw[j] = *((const f32x4*)a.lnw + F.lane + 64 * j);
    for (int m = gw; m < MT; m += NGW) {
        const float* xrow = m < MP ? a.xp + (size_t)m * DM : a.xs + (size_t)(m - MP) * DM;
        const f32x4* xr = (const f32x4*)xrow + F.lane;
        f32x4 v[4]; float s = 0.f;
#pragma unroll
        for (int j = 0; j < 4; ++j) { v[j] = xr[64 * j]; s += (v[j].x * v[j].x + v[j].y * v[j].y) + (v[j].z * v[j].z + v[j].w * v[j].w); }
        const float rstd = 1.0f / sqrtf(wave_sum(s) * (1.f / DM) + NORM_EPS);
        unsigned long long* o8 = (unsigned long long*)(XN + (size_t)m * DM) + F.lane;
#pragma unroll
        for (int j = 0; j < 4; ++j) { const f32x4 y = v[j] * rstd * lw[j]; o8[64 * j] = (unsigned long long)cvtpk(y.x, y.y) | ((unsigned long long)cvtpk(y.z, y.w) << 32); }
    }
    float* rc = (float*)(ws + WS_ROPE); float* rs = rc + 8200 * 8;
    for (int idx = F.bid * 512 + F.tid; idx < 8200 * 8; idx += F.G * 512) {
        const int pos = idx >> 3, i = idx & 7;
        const double f = (i == 0) ? 1.0 : (i == 1) ? 0.19392274474868576 : (i == 2) ? 0.03760603093086393 : (i == 3) ? 0.007292664737217109 : (i == 4) ? 0.001414213562373095 :
                         (i == 5) ? 0.0002742481756762073 : (i == 6) ? 5.318295896944988e-05 : 1.031338537721246e-05;
        float s, c; sincos_acc((double)pos * f, s, c); rc[idx] = c; rs[idx] = s;
    }
}

__device__ __forceinline__ bf16x8 pack8(const f32x16& x, int s8) {
    v4u p; p.x = cvtpk(x[s8 + 0], x[s8 + 1]); p.y = cvtpk(x[s8 + 2], x[s8 + 3]); p.z = cvtpk(x[s8 + 4], x[s8 + 5]); p.w = cvtpk(x[s8 + 6], x[s8 + 7]);
    return __builtin_bit_cast(bf16x8, p);
}
template <bool SB, class KF, class VF, class MK>
__device__ __forceinline__ void attn_wave(const bf16x8 (&qf)[4], const KF& kf, const VF& vf, const MK& valid, int lane, f32x16 (&o)[2], float& lse2) {
    const int q = lane & 31, hi = lane >> 5;
    f32x16 x[5];
#pragma unroll
    for (int j = 0; j < 5; ++j) {
#pragma unroll
        for (int r = 0; r < 16; ++r) x[j][r] = 0.f;
#pragma unroll
        for (int d0 = 0; d0 < 4; ++d0) x[j] = __builtin_amdgcn_mfma_f32_32x32x16_bf16(kf(j, d0), qf[d0], x[j], 0, 0, 0);
        if (SB) __builtin_amdgcn_sched_barrier(0);
    }
    float m = -1e30f;
#pragma unroll
    for (int j = 0; j < 5; ++j)
#pragma unroll
        for (int r = 0; r < 16; ++r) { const bool ok = valid(q, 32 * j + crow(r, hi)); const float v = ok ? x[j][r] : -1e30f; x[j][r] = v; m = fmaxf(m, v); }
    m = fmaxf(m, __shfl_xor(m, 32));
    float l = 0.f;
#pragma unroll
    for (int j = 0; j < 5; ++j)
#pragma unroll
        for (int r = 0; r < 16; ++r) { const float p = __builtin_amdgcn_exp2f(x[j][r] - m); x[j][r] = p; l += p; }
    l += __shfl_xor(l, 32);
#pragma unroll
    for (int r = 0; r < 16; ++r) { o[0][r] = 0.f; o[1][r] = 0.f; }
#pragma unroll
    for (int j = 0; j < 5; ++j)
#pragma unroll
        for (int s = 0; s < 2; ++s) { const bf16x8 pa = pack8(x[j], 8 * s);
#pragma unroll
            for (int c = 0; c < 2; ++c) o[c] = __builtin_amdgcn_mfma_f32_32x32x16_bf16(pa, vf(j, s, c), o[c], 0, 0, 0);
            if (SB) __builtin_amdgcn_sched_barrier(0); }
    lse2 = m + __log2f(l);
#pragma unroll
    for (int r = 0; r < 16; ++r) { const float li = __shfl(l, crow(r, hi)); const float inv = 1.0f / li; o[0][r] *= inv; o[1][r] *= inv; }
}

constexpr int ATT_PITCH = 144;
constexpr int ATT_KOFF = 0, ATT_VOFF = 384 * ATT_PITCH;
__device__ __forceinline__ void attn_prompt_unit(Frame& F, const Args& a, int u, unsigned char* ws, float* outp) {
    const bf16* P = (const bf16*)(ws + WS_P); bf16* OG = (bf16*)(ws + WS_OG); float* LSE = (float*)(ws + WS_LSE);
    const int g = u >> 10, rem = u & 1023, b = rem >> 8, rq = (rem & 255) >> 3, h = rem & 7;
    const int d = 1 << (2 * g);
    const int nqb = 32 >> (2 * g);
    const int r = rq / nqb, qb = rq % nqb;
    const int l0 = qb * 256;
    const size_t rowb = (size_t)b * SEQ + r;
    LAS unsigned char* Kl = F.lds + ATT_KOFF; LAS unsigned char* Vl = F.lds + ATT_VOFF;
#pragma unroll
    for (int i = 0; i < 6; ++i) { const int ci = F.tid + 512 * i, row = ci >> 3, ch = ci & 7; const int l = l0 - 128 + row;
        v4u kv = {0u, 0u, 0u, 0u}, vv = {0u, 0u, 0u, 0u};
        if (l >= 0) { const bf16* src = P + (rowb + (size_t)d * l) * NPROJ + g * 512 + h * 64 + ch * 8; kv = *(const v4u*)(src + PC_K); vv = *(const v4u*)(src + PC_V); }
        *(LAS v4u*)(Kl + row * ATT_PITCH + ch * 16) = kv; *(LAS v4u*)(Vl + row * ATT_PITCH + ch * 16) = vv; }
    const int w = F.wave, lane = F.lane, hi = lane >> 5, q = lane & 31;
    bf16x8 qf[4];
    { const bf16* qsrc = P + (rowb + (size_t)d * (l0 + 32 * w + q)) * NPROJ + PC_Q + g * 512 + h * 64 + 8 * hi;
#pragma unroll
      for (int d0 = 0; d0 < 4; ++d0) qf[d0] = *(const bf16x8*)(qsrc + 16 * d0); }
    WG_BAR();
    const LAS unsigned char* kb = Kl + (32 * w + q) * ATT_PITCH + hi * 16;
    const int q_ = (lane & 15) >> 2, p_ = lane & 3, blk = (lane >> 4) & 1;
    const LAS unsigned char* vb = Vl + (32 * w + 4 * hi + q_) * ATT_PITCH + (16 * blk + 4 * p_) * 2;
    auto kf = [&](int j, int d0) __attribute__((always_inline)) -> bf16x8 { return *(const LAS bf16x8*)(kb + j * 32 * ATT_PITCH + d0 * 32); };
    auto vf = [&](int j, int s, int c) __attribute__((always_inline)) -> bf16x8 {
        const LAS unsigned char* p = vb + (32 * j + 16 * s) * ATT_PITCH + c * 64;
        const v4i16_t lo = __builtin_amdgcn_ds_read_tr16_b64_v4i16((LAS v4i16_t*)p);
        const v4i16_t hh = __builtin_amdgcn_ds_read_tr16_b64_v4i16((LAS v4i16_t*)(p + 8 * ATT_PITCH));
        return (bf16x8){lo[0], lo[1], lo[2], lo[3], hh[0], hh[1], hh[2], hh[3]}; };
    const int kpos0 = l0 + 32 * w - 128;
    auto valid = [&](int qq, int kk) __attribute__((always_inline)) -> bool { const int dist = qq + 128 - kk; return dist >= 0 && dist <= 128 && (kpos0 + kk) >= 0; };
    f32x16 o[2]; float lse2;
    attn_wave<false>(qf, kf, vf, valid, lane, o, lse2);
    const size_t orow0 = (size_t)g * MT + rowb + (size_t)d * (l0 + 32 * w);
#pragma unroll
    for (int rr = 0; rr < 16; ++rr) { const int qq = crow(rr, hi); bf16* dst = OG + (orow0 + (size_t)d * qq) * 512 + h * 64 + q;
        dst[0] = (bf16)(cvtpk(o[0][rr], 0.f) & 0xffffu); dst[32] = (bf16)(cvtpk(o[1][rr], 0.f) & 0xffffu); }
    if (hi == 0) LSE[(orow0 + (size_t)d * q) * 8 + h] = lse2;
    WG_BAR();
}
__device__ __forceinline__ void attn_sample_unit(Frame& F, const Args& a, int su, unsigned char* ws, float* outp) {
    const bf16* P = (const bf16*)(ws + WS_P); bf16* OG = (bf16*)(ws + WS_OG); float* LSE = (float*)(ws + WS_LSE);
    const int db = su / 13, k13 = su % 13;
    const int g = k13 == 0 ? 0 : (k13 < 5 ? 1 : 2);
    const int sub = k13 == 0 ? 0 : (k13 < 5 ? k13 - 1 : k13 - 5);
    const int d = 1 << (2 * g), nq = 8 >> (g == 0 ? 0 : (g == 1 ? 2 : 3));
    const int Wlen = 128 << (2 * g);
    const float* cp0 = a.c128; const float* cp1 = a.c512; const float* cp2 = a.c2048; { size_t z_ = 0; asm volatile("" : "+s"(z_)); cp0 += z_; cp1 += z_; cp2 += z_; }
    const float* cache = g == 0 ? cp0 : (g == 1 ? cp1 : cp2);
    const int h = F.wave, lane = F.lane, hi = lane >> 5, q = lane & 31;
    const float* kc = cache + (size_t)db * Wlen * 1024 + h * 64;
    const size_t srow0 = (size_t)MP + db * 8;
    bf16x8 qf[4];
    { const bf16* qsrc = P + (srow0 + sub + d * q) * NPROJ + PC_Q + g * 512 + h * 64 + 8 * hi;
#pragma unroll
      for (int d0 = 0; d0 < 4; ++d0) { bf16x8 z = {0, 0, 0, 0, 0, 0, 0, 0}; if (q < nq) z = *(const bf16x8*)(qsrc + 16 * d0); qf[d0] = z; } }
    auto kf = [&](int j, int d0) __attribute__((always_inline)) -> bf16x8 {
        if (j < 4) { const float* p = kc + (size_t)(sub + d * (32 * j + q)) * 1024 + 16 * d0 + 8 * hi; const f32x4 x0 = *(const f32x4*)p, x1 = *(const f32x4*)(p + 4);
            v4u w; w.x = cvtpk(x0[0], x0[1]); w.y = cvtpk(x0[2], x0[3]); w.z = cvtpk(x1[0], x1[1]); w.w = cvtpk(x1[2], x1[3]); return __builtin_bit_cast(bf16x8, w); }
        bf16x8 z = {0, 0, 0, 0, 0, 0, 0, 0};
        if (q < nq) z = *(const bf16x8*)(P + (srow0 + sub + d * q) * NPROJ + PC_K + g * 512 + h * 64 + 16 * d0 + 8 * hi);
        return z; };
    auto vf = [&](int j, int s, int c) __attribute__((always_inline)) -> bf16x8 {
        float f[8];
#pragma unroll
        for (int jj = 0; jj < 8; ++jj) { const int kr = 16 * s + 8 * (jj >> 2) + 4 * hi + (jj & 3);
            if (j < 4) f[jj] = kc[(size_t)(sub + d * (32 * j + kr)) * 1024 + 512 + 32 * c + q];
            else { float t = 0.f; if (kr < 8 && kr < nq) t = bf2f(P[(srow0 + sub + d * kr) * NPROJ + PC_V + g * 512 + h * 64 + 32 * c + q]); f[jj] = t; } }
        v4u w; w.x = cvtpk(f[0], f[1]); w.y = cvtpk(f[2], f[3]); w.z = cvtpk(f[4], f[5]); w.w = cvtpk(f[6], f[7]); return __builtin_bit_cast(bf16x8, w); };
    auto valid = [&](int qq, int slot) __attribute__((always_inline)) -> bool { return qq < nq && (slot < 128 ? slot >= qq : ((slot - 128) <= qq && (slot - 128) < nq)); };
    f32x16 o[2]; float lse2;
    attn_wave<true>(qf, kf, vf, valid, lane, o, lse2);
    const size_t orow0 = (size_t)g * MT + srow0 + sub;
#pragma unroll
    for (int rr = 0; rr < 4; ++rr) { const int qq = crow(rr, hi);
        if (qq < nq) { bf16* dst = OG + (orow0 + (size_t)d * qq) * 512 + h * 64 + q; dst[0] = (bf16)(cvtpk(o[0][rr], 0.f) & 0xffffu); dst[32] = (bf16)(cvtpk(o[1][rr], 0.f) & 0xffffu); } }
    if (hi == 0 && q < nq) LSE[(orow0 + (size_t)d * q) * 8 + h] = lse2;
}

constexpr int GP = 72;
__device__ __forceinline__ void gla_gates(const Args& a, const float* glr_rows, int h, int wave, int lane, LAS float* tot, float (&b)[8], float& blast) {
    float wa[16];
#pragma unroll
    for (int r = 0; r < 16; ++r) wa[r] = a.wa2[r * 256 + h * 64 + lane];
    const float bias = a.ba[h * 64 + lane];
    float run = 0.f;
#pragma unroll
    for (int i = 0; i < 8; ++i) { const f32x4* gp4 = (const f32x4*)(glr_rows + (size_t)(8 * wave + i) * 16); float gp = bias;
#pragma unroll
        for (int r4 = 0; r4 < 4; ++r4) { const f32x4 gv = gp4[r4]; gp += gv[0] * wa[4 * r4] + gv[1] * wa[4 * r4 + 1] + gv[2] * wa[4 * r4 + 2] + gv[3] * wa[4 * r4 + 3]; }
        run += logsigf_(gp) * (1.0f / 16.0f); b[i] = run; }
    tot[wave * 64 + lane] = run;
    WG_BAR();
    float pre = 0.f, all = 0.f;
#pragma unroll
    for (int s = 0; s < 8; ++s) { const float tv = tot[s * 64 + lane]; all += tv; pre += (s < wave) ? tv : 0.f; }
#pragma unroll
    for (int i = 0; i < 8; ++i) b[i] += pre;
    blast = all;
}
__device__ __forceinline__ void gla_stage_vT(Frame& F, const bf16* P, size_t row0, int h, LAS bf16* vT) {
    const int v = F.tid & 127, tq = F.tid >> 7;
    unsigned pk[8];
#pragma unroll
    for (int i = 0; i < 8; ++i) { const unsigned lo = P[(row0 + 16 * tq + 2 * i) * NPROJ + PC_GV + h * 128 + v], hi2 = P[(row0 + 16 * tq + 2 * i + 1) * NPROJ + PC_GV + h * 128 + v]; pk[i] = lo | (hi2 << 16); }
    LAS v4u* dst = (LAS v4u*)((LAS unsigned char*)vT + v * (GP * 2) + 32 * tq);
    dst[0] = (v4u){pk[0], pk[1], pk[2], pk[3]}; dst[1] = (v4u){pk[4], pk[5], pk[6], pk[7]};
}
__device__ __forceinline__ bf16x8 ldfrag(const LAS bf16* base, int row, int kofs) { return *(const LAS bf16x8*)(base + row * GP + kofs); }

__device__ __forceinline__ void gla_g1_unit(Frame& F, const Args& a, int chunk, unsigned char* ws, float* outp) {
    const bf16* P = (const bf16*)(ws + WS_P); const float* GLR = (const float*)(ws + WS_GLR); float* UT = (float*)(ws + WS_UT); float* DC = (float*)(ws + WS_DC);
    const int bh = chunk >> 7, c = chunk & 127, b = bh >> 2, h = bh & 3;
    const size_t row0 = (size_t)b * SEQ + c * 64;
    LAS bf16* kdT = (LAS bf16*)(F.lds + 0);
    LAS bf16* vT = (LAS bf16*)(F.lds + 9216);
    LAS float* tot = (LAS float*)(F.lds + 27648);
    const int lane = F.lane, w = F.wave, hi = lane >> 5;
    float bb[8], blast;
    gla_gates(a, GLR + row0 * 16, h, w, lane, tot, bb, blast);
    { unsigned pk[4];
#pragma unroll
      for (int i = 0; i < 4; ++i) { const float k0 = bf2f(P[(row0 + 8 * w + 2 * i) * NPROJ + PC_GK + h * 64 + lane]) * __expf(blast - bb[2 * i]);
          const float k1 = bf2f(P[(row0 + 8 * w + 2 * i + 1) * NPROJ + PC_GK + h * 64 + lane]) * __expf(blast - bb[2 * i + 1]); pk[i] = cvtpk(k0, k1); }
      *(LAS v4u*)((LAS unsigned char*)kdT + lane * (GP * 2) + 16 * w) = (v4u){pk[0], pk[1], pk[2], pk[3]}; }
    gla_stage_vT(F, P, row0, h, vT);
    if (w == 0) DC[(size_t)chunk * 64 + lane] = __expf(blast);
    WG_BAR();
    const int vt = w >> 1, kt = w & 1;
    f32x16 acc;
#pragma unroll
    for (int r = 0; r < 16; ++r) acc[r] = 0.f;
#pragma unroll
    for (int s = 0; s < 4; ++s) acc = __builtin_amdgcn_mfma_f32_32x32x16_bf16(ldfrag(vT, 32 * vt + (lane & 31), 16 * s + 8 * hi), ldfrag(kdT, 32 * kt + (lane & 31), 16 * s + 8 * hi), acc, 0, 0, 0);
    float* ut = UT + (size_t)chunk * 8192;
#pragma unroll
    for (int r = 0; r < 16; ++r) ut[(32 * vt + crow(r, hi)) * 64 + 32 * kt + (lane & 31)] = acc[r];
    WG_BAR();
}
__device__ __forceinline__ void gla_scan(Frame& F, const Args& a, unsigned char* ws, float* outp) {
    const float* UT = (const float*)(ws + WS_UT); const float* DC = (const float*)(ws + WS_DC); bf16* ST = (bf16*)(ws + WS_ST);
    for (int e = F.bid * 512 + F.tid; e < 16 * 8192; e += F.G * 512) {
        const int bh = e >> 13, vk = e & 8191, v = vk >> 6, k = vk & 63;
        const float* ut = UT + (size_t)bh * 128 * 8192 + vk; const float* dc = DC + (size_t)bh * 128 * 64 + k; bf16* st = ST + (size_t)bh * 128 * 8192 + vk;
        float S = 0.f;
        for (int c0 = 0; c0 < 128; c0 += 16) {
            float uu[16], dd[16];
#pragma unroll
            for (int i = 0; i < 16; ++i) { uu[i] = ut[(size_t)(c0 + i) * 8192]; dd[i] = dc[(c0 + i) * 64]; }
#pragma unroll
            for (int i = 0; i < 16; ++i) { st[(size_t)(c0 + i) * 8192] = (bf16)(cvtpk(S, 0.f) & 0xffffu); S = dd[i] * S + uu[i]; }
        }
        outp[OFF_GLAP + ((size_t)bh * 64 + k) * 128 + v] = S;
    }
}
__device__ __forceinline__ void gla_g3_unit(Frame& F, const Args& a, int chunk, unsigned char* ws, float* outp) {
    const bf16* P = (const bf16*)(ws + WS_P); const float* GLR = (const float*)(ws + WS_GLR); const bf16* ST = (const bf16*)(ws + WS_ST); bf16* A2 = (bf16*)(ws + WS_A2);
    const int bh = chunk >> 7, c = chunk & 127, b = bh >> 2, h = bh & 3;
    const size_t row0 = (size_t)b * SEQ + c * 64;
    LAS bf16* qeL = (LAS bf16*)(F.lds + 0); LAS bf16* keL = (LAS bf16*)(F.lds + 9216); LAS bf16* attL = (LAS bf16*)(F.lds + 18432);
    LAS bf16* vT = (LAS bf16*)(F.lds + 27648); LAS bf16* sTL = (LAS bf16*)(F.lds + 46080); LAS float* tot = (LAS float*)(F.lds + 64512); LAS float* oL = (LAS float*)(F.lds + 66560);
    const int lane = F.lane, w = F.wave, hi = lane >> 5;
    float bb[8], blast;
    gla_gates(a, GLR + row0 * 16, h, w, lane, tot, bb, blast);
#pragma unroll
    for (int i = 0; i < 8; ++i) { const size_t pr = (row0 + 8 * w + i) * NPROJ + h * 64 + lane;
        const float qv = bf2f(P[pr + PC_GQ]) * 0.125f * __expf(bb[i]); const float kv = bf2f(P[pr + PC_GK]) * __expf(-bb[i]);
        qeL[(8 * w + i) * GP + lane] = (bf16)(cvtpk(qv, 0.f) & 0xffffu); keL[(8 * w + i) * GP + lane] = (bf16)(cvtpk(kv, 0.f) & 0xffffu); }
    gla_stage_vT(F, P, row0, h, vT);
#pragma unroll
    for (int i = 0; i < 2; ++i) { const int ci = F.tid + 512 * i, v = ci >> 3, ch = ci & 7;
        *(LAS v4u*)((LAS unsigned char*)sTL + v * (GP * 2) + ch * 16) = *(const v4u*)(ST + (size_t)chunk * 8192 + v * 64 + ch * 8); }
    WG_BAR();
    const int tt = w >> 2, vt = w & 3;
    f32x16 oacc;
#pragma unroll
    for (int r = 0; r < 16; ++r) oacc[r] = 0.f;
#pragma unroll
    for (int s = 0; s < 4; ++s) oacc = __builtin_amdgcn_mfma_f32_32x32x16_bf16(ldfrag(qeL, 32 * tt + (lane & 31), 16 * s + 8 * hi), ldfrag(sTL, 32 * vt + (lane & 31), 16 * s + 8 * hi), oacc, 0, 0, 0);
    if (w < 4) { const int at = w >> 1, as = w & 1;
        f32x16 att;
#pragma unroll
        for (int r = 0; r < 16; ++r) att[r] = 0.f;
#pragma unroll
        for (int s = 0; s < 4; ++s) att = __builtin_amdgcn_mfma_f32_32x32x16_bf16(ldfrag(qeL, 32 * at + (lane & 31), 16 * s + 8 * hi), ldfrag(keL, 32 * as + (lane & 31), 16 * s + 8 * hi), att, 0, 0, 0);
#pragma unroll
        for (int r = 0; r < 16; ++r) { const int t = 32 * at + crow(r, hi), sx = 32 * as + (lane & 31); const float v = (sx <= t) ? att[r] : 0.f; attL[t * GP + sx] = (bf16)(cvtpk(v, 0.f) & 0xffffu); } }
    WG_BAR();
#pragma unroll
    for (int s = 0; s < 4; ++s) oacc = __builtin_amdgcn_mfma_f32_32x32x16_bf16(ldfrag(attL, 32 * tt + (lane & 31), 16 * s + 8 * hi), ldfrag(vT, 32 * vt + (lane & 31), 16 * s + 8 * hi), oacc, 0, 0, 0);
#pragma unroll
    for (int r = 0; r < 16; ++r) oL[(32 * tt + crow(r, hi)) * 132 + 32 * vt + (lane & 31)] = oacc[r];
    WG_BAR();
    { const int t = F.tid >> 3, v8 = F.tid & 7;
      float ov[16]; float ss = 0.f;
#pragma unroll
      for (int i = 0; i < 4; ++i) { const f32x4 x = *(const LAS f32x4*)(oL + t * 132 + 16 * v8 + 4 * i); ov[4 * i] = x[0]; ov[4 * i + 1] = x[1]; ov[4 * i + 2] = x[2]; ov[4 * i + 3] = x[3]; ss += (x[0] * x[0] + x[1] * x[1]) + (x[2] * x[2] + x[3] * x[3]); }
      ss += __shfl_xor(ss, 1); ss += __shfl_xor(ss, 2); ss += __shfl_xor(ss, 4);
      const float rstd = 1.0f / sqrtf(ss * (1.0f / 128.0f) + NORM_EPS);
      const bf16* gz = P + (row0 + t) * NPROJ + PC_GZ + h * 128 + 16 * v8; const v4u g0 = *(const v4u*)gz, g1 = *(const v4u*)(gz + 8);
      const float* nw = a.gnw + 16 * v8;
      const unsigned gzw[8] = {g0.x, g0.y, g0.z, g0.w, g1.x, g1.y, g1.z, g1.w}; unsigned ow[8];
#pragma unroll
      for (int i = 0; i < 8; ++i) { const float y0 = ov[2 * i] * rstd * nw[2 * i] * siluf_(bflo(gzw[i])), y1 = ov[2 * i + 1] * rstd * nw[2 * i + 1] * siluf_(bfhi(gzw[i])); ow[i] = cvtpk(y0, y1); }
      bf16* dst = A2 + (row0 + t) * 512 + h * 128 + 16 * v8; *(v4u*)dst = (v4u){ow[0], ow[1], ow[2], ow[3]}; *(v4u*)(dst + 8) = (v4u){ow[4], ow[5], ow[6], ow[7]}; }
    WG_BAR();
}
__device__ __forceinline__ void gla_sample_unit(Frame& F, const Args& a, int su, unsigned char* ws, float* outp) {
    const bf16* P = (const bf16*)(ws + WS_P); const float* GLR = (const float*)(ws + WS_GLR); bf16* A2 = (bf16*)(ws + WS_A2);
    const int db = su >> 2, h = su & 3; const size_t row0 = (size_t)MP + db * 8;
    LAS float* laL = (LAS float*)(F.lds + 0); LAS float* qeL = laL + 512; LAS float* keL = qeL + 512; LAS float* kdL = keL + 512; LAS float* decL = kdL + 512; LAS float* attL = decL + 64;
    LAS float* poL = attL + 64;
    LAS float* oL = poL + 4096;
    const int lane = F.lane, w = F.wave;
    { const int t = w, k = lane; float gp = a.ba[h * 64 + k];
#pragma unroll
      for (int r = 0; r < 16; ++r) gp += GLR[(row0 + t) * 16 + r] * a.wa2[r * 256 + h * 64 + k];
      laL[t * 64 + k] = logsigf_(gp) * (1.0f / 16.0f); }
    WG_BAR();
    { const int t = w, k = lane; float bsum = 0.f, all = 0.f;
#pragma unroll
      for (int i = 0; i < 8; ++i) { const float v = laL[i * 64 + k]; all += v; bsum += (i <= t) ? v : 0.f; }
      const size_t pr = (row0 + t) * NPROJ + h * 64 + k; const float gq = bf2f(P[pr + PC_GQ]), gk = bf2f(P[pr + PC_GK]);
      qeL[t * 64 + k] = gq * 0.125f * __expf(bsum); keL[t * 64 + k] = gk * __expf(-bsum); kdL[t * 64 + k] = gk * __expf(all - bsum);
      if (t == 0) decL[k] = __expf(all); }
    WG_BAR();
    if (F.tid < 64) { const int t = F.tid >> 3, s = F.tid & 7; float acc = 0.f;
        for (int k = 0; k < 64; ++k) acc += qeL[t * 64 + k] * keL[s * 64 + k];
        attL[t * 8 + s] = (s <= t) ? acc : 0.f; }
    const int v = F.tid & 127, kq = F.tid >> 7;
    float vv[8];
#pragma unroll
    for (int s = 0; s < 8; ++s) vv[s] = bf2f(P[(row0 + s) * NPROJ + PC_GV + h * 128 + v]);
    { float po[8];
#pragma unroll
      for (int t = 0; t < 8; ++t) po[t] = 0.f;
      const size_t sbase = ((size_t)(db * 4 + h) * 64) * 128 + v;
#pragma unroll 4
      for (int kk = 0; kk < 16; ++kk) { const int k = 16 * kq + kk; const float s0 = a.sgla[sbase + (size_t)k * 128];
          float ns = decL[k] * s0;
#pragma unroll
          for (int s = 0; s < 8; ++s) ns += kdL[s * 64 + k] * vv[s];
          outp[OFF_GLAS + sbase + (size_t)k * 128] = ns;
#pragma unroll
          for (int t = 0; t < 8; ++t) po[t] += qeL[t * 64 + k] * s0; }
#pragma unroll
      for (int t = 0; t < 8; ++t) poL[(kq * 8 + t) * 128 + v] = po[t]; }
    WG_BAR();
#pragma unroll
    for (int i = 0; i < 2; ++i) { const int t = 2 * kq + i; float o = (poL[(0 * 8 + t) * 128 + v] + poL[(1 * 8 + t) * 128 + v]) + (poL[(2 * 8 + t) * 128 + v] + poL[(3 * 8 + t) * 128 + v]);
#pragma unroll
        for (int s = 0; s < 8; ++s) o += attL[t * 8 + s] * vv[s];
        oL[t * 128 + v] = o; }
    WG_BAR();
    { const int t = w; const float o0 = oL[t * 128 + 2 * lane], o1 = oL[t * 128 + 2 * lane + 1];
      const float ss = wave_sum(o0 * o0 + o1 * o1); const float rstd = 1.0f / sqrtf(ss * (1.0f / 128.0f) + NORM_EPS);
      const unsigned gz = *(const unsigned*)(P + (row0 + t) * NPROJ + PC_GZ + h * 128 + 2 * lane);
      const float y0 = o0 * rstd * a.gnw[2 * lane] * siluf_(bflo(gz)), y1 = o1 * rstd * a.gnw[2 * lane + 1] * siluf_(bfhi(gz));
      *(unsigned*)(A2 + (row0 + t) * 512 + h * 128 + 2 * lane) = cvtpk(y0, y1); }
    WG_BAR();
}
__device__ __forceinline__ void combine_rows(Frame& F, const Args& a, unsigned char* ws, float* outp) {
    const bf16* P = (const bf16*)(ws + WS_P); const bf16* OG = (const bf16*)(ws + WS_OG); const float* LSE = (const float*)(ws + WS_LSE); bf16* A1 = (bf16*)(ws + WS_A1);
    const int gw = F.bid * NWAVES + F.wave, NGW = F.G * NWAVES, lane = F.lane, c0 = 8 * lane, head = lane >> 3;
    for (int row = gw; row < MT; row += NGW) {
        const float l0 = LSE[((size_t)0 * MT + row) * 8 + head], l1 = LSE[((size_t)1 * MT + row) * 8 + head], l2 = LSE[((size_t)2 * MT + row) * 8 + head];
        const float mx = fmaxf(l0, fmaxf(l1, l2));
        float w0 = __builtin_amdgcn_exp2f(l0 - mx), w1 = __builtin_amdgcn_exp2f(l1 - mx), w2 = __builtin_amdgcn_exp2f(l2 - mx);
        const float inv = 1.0f / (w0 + w1 + w2); w0 *= inv; w1 *= inv; w2 *= inv;
        const v4u o0 = *(const v4u*)(OG + ((size_t)0 * MT + row) * 512 + c0), o1 = *(const v4u*)(OG + ((size_t)1 * MT + row) * 512 + c0), o2 = *(const v4u*)(OG + ((size_t)2 * MT + row) * 512 + c0);
        const v4u az = *(const v4u*)(P + (size_t)row * NPROJ + PC_AZ + c0);
        const unsigned a0[4] = {o0.x, o0.y, o0.z, o0.w}, a1[4] = {o1.x, o1.y, o1.z, o1.w}, a2[4] = {o2.x, o2.y, o2.z, o2.w}, zz[4] = {az.x, az.y, az.z, az.w}; unsigned ow[4];
#pragma unroll
        for (int i = 0; i < 4; ++i) { const float y0 = (w0 * bflo(a0[i]) + w1 * bflo(a1[i]) + w2 * bflo(a2[i])) * siluf_(bflo(zz[i])), y1 = (w0 * bfhi(a0[i]) + w1 * bfhi(a1[i]) + w2 * bfhi(a2[i])) * siluf_(bfhi(zz[i])); ow[i] = cvtpk(y0, y1); }
        *(v4u*)(A1 + (size_t)row * 512 + c0) = (v4u){ow[0], ow[1], ow[2], ow[3]};
    }
}
__device__ __forceinline__ void final_norm(Frame& F, const Args& a, unsigned char* ws, float* outp) {
    const float* rowss = (const float*)(ws + WS_ROWSS);
    const int gw = F.bid * NWAVES + F.wave, NGW = F.G * NWAVES, lane = F.lane;
    f32x4 fw[4];
#pragma unroll
    for (int j = 0; j < 4; ++j) fw[j] = *((const f32x4*)a.fnw + lane + 64 * j);
    for (int row = gw; row < MT; row += NGW) {
        float ss = rowss[(size_t)row * 16 + (lane & 15)];
        ss += __shfl_xor(ss, 1); ss += __shfl_xor(ss, 2); ss += __shfl_xor(ss, 4); ss += __shfl_xor(ss, 8);
        const float rstd = 1.0f / sqrtf(ss * (1.0f / 1024.0f) + NORM_EPS);
        f32x4* yr = (f32x4*)(outp + OFF_Y + (size_t)row * 1024) + lane;
#pragma unroll
        for (int j = 0; j < 4; ++j) { const f32x4 v = yr[64 * j]; yr[64 * j] = v * rstd * fw[j]; }
    }
}

#define LDS_BAR() do { asm volatile("s_waitcnt lgkmcnt(0)" ::: "memory"); __builtin_amdgcn_s_barrier(); asm volatile("" ::: "memory"); } while (0)
__device__ __forceinline__ bf16x8 tr_frag(const LAS unsigned char* T, int PB, int k0, int x0, int lane) {
    const int h = lane >> 5, blk = (lane >> 4) & 1, q_ = (lane & 15) >> 2, p_ = lane & 3;
    const LAS unsigned char* p = T + (k0 + 8 * h + q_) * PB + (x0 + 16 * blk + 4 * p_) * 2;
    const v4i16_t lo = __builtin_amdgcn_ds_read_tr16_b64_v4i16((LAS v4i16_t*)p);
    const v4i16_t hh = __builtin_amdgcn_ds_read_tr16_b64_v4i16((LAS v4i16_t*)(p + 4 * PB));
    return (bf16x8){lo[0], lo[1], lo[2], lo[3], hh[0], hh[1], hh[2], hh[3]};
}
__device__ __forceinline__ bf16x8 tr_frag_acc(const LAS unsigned char* T, int PB, int k0, int x0, int lane) {
    const int h = lane >> 5, blk = (lane >> 4) & 1, q_ = (lane & 15) >> 2, p_ = lane & 3;
    const LAS unsigned char* p = T + (k0 + 4 * h + q_) * PB + (x0 + 16 * blk + 4 * p_) * 2;
    const v4i16_t lo = __builtin_amdgcn_ds_read_tr16_b64_v4i16((LAS v4i16_t*)p);
    const v4i16_t hh = __builtin_amdgcn_ds_read_tr16_b64_v4i16((LAS v4i16_t*)(p + 8 * PB));
    return (bf16x8){lo[0], lo[1], lo[2], lo[3], hh[0], hh[1], hh[2], hh[3]};
}

struct AttnU { const bf16* kv; const bf16* q; size_t orow0; int d, l0, h; };
__device__ __forceinline__ AttnU attn_decode(const bf16* P, int u) {
    AttnU A; const int g = u >> 10, rem = u & 1023, b = rem >> 8, rq = (rem & 255) >> 3, h = rem & 7;
    const int d = 1 << (2 * g), nqb = 32 >> (2 * g), r = rq / nqb, qb = rq % nqb;
    const size_t rowb = (size_t)b * SEQ + r;
    A.d = d; A.l0 = qb * 256; A.h = h;
    A.kv = P + rowb * NPROJ + g * 512 + h * 64;
    A.q = P + rowb * NPROJ + PC_Q + g * 512 + h * 64;
    A.orow0 = (size_t)g * MT + rowb;
    return A;
}
__device__ __forceinline__ void attn_prompt_phase(Frame& F, unsigned char* ws, int first, int stride) {
    const bf16* P = (const bf16*)(ws + WS_P); bf16* OG = (bf16*)(ws + WS_OG); float* LSE = (float*)(ws + WS_LSE);
    LAS unsigned char* Kl = F.lds + ATT_KOFF; LAS unsigned char* Vl = F.lds + ATT_VOFF;
    const int w = F.wave, lane = F.lane, hi = lane >> 5, q = lane & 31, tid = F.tid;
    int u = first;
    if (u >= 3072) return;
    AttnU U = attn_decode(P, u);
    v4u pre[6]; bf16x8 qn[4];
#define ATT_LOAD(dst, UU, PCOL) do { _Pragma("unroll") for (int i = 0; i < 6; ++i) { const int ci = tid + 512 * i, row = ci >> 3, ch = ci & 7; const int l = (UU).l0 - 128 + row; \
        v4u t_ = {0u, 0u, 0u, 0u}; if (l >= 0) t_ = *(const v4u*)((UU).kv + (size_t)(UU).d * l * NPROJ + (PCOL) + ch * 8); dst[i] = t_; } } while (0)
#define ATT_STORE(src, BASE) do { _Pragma("unroll") for (int i = 0; i < 6; ++i) { const int ci = tid + 512 * i, row = ci >> 3, ch = ci & 7; *(LAS v4u*)((BASE) + row * ATT_PITCH + ch * 16) = src[i]; } } while (0)
#define ATT_LOADQ(UU) do { const bf16* qsrc = (UU).q + (size_t)(UU).d * ((UU).l0 + 32 * w + q) * NPROJ + 8 * hi; _Pragma("unroll") for (int d0 = 0; d0 < 4; ++d0) qn[d0] = *(const bf16x8*)(qsrc + 16 * d0); } while (0)
    ATT_LOAD(pre, U, PC_K); ATT_LOADQ(U);
    const LAS unsigned char* kb = Kl + (32 * w + q) * ATT_PITCH + hi * 16;
    while (true) {
        ATT_STORE(pre, Kl);
        ATT_LOAD(pre, U, PC_V);
        bf16x8 qf[4];
#pragma unroll
        for (int d0 = 0; d0 < 4; ++d0) qf[d0] = qn[d0];
        LDS_BAR();
        f32x16 x[5];
#pragma unroll
        for (int j = 0; j < 5; ++j) {
#pragma unroll
            for (int r = 0; r < 16; ++r) x[j][r] = 0.f;
#pragma unroll
            for (int d0 = 0; d0 < 4; ++d0) x[j] = __builtin_amdgcn_mfma_f32_32x32x16_bf16(*(const LAS bf16x8*)(kb + j * 32 * ATT_PITCH + d0 * 32), qf[d0], x[j], 0, 0, 0);
        }
        const int kpos0 = U.l0 + 32 * w - 128;
        float m = -1e30f;
#pragma unroll
        for (int j = 0; j < 5; ++j)
#pragma unroll
            for (int r = 0; r < 16; ++r) { const int kk = 32 * j + crow(r, hi); const int dist = q + 128 - kk; const bool ok = dist >= 0 && dist <= 128 && (kpos0 + kk) >= 0;
                const float v = ok ? x[j][r] : -1e30f; x[j][r] = v; m = fmaxf(m, v); }
        m = fmaxf(m, __shfl_xor(m, 32));
        float l = 0.f;
#pragma unroll
        for (int j = 0; j < 5; ++j)
#pragma unroll
            for (int r = 0; r < 16; ++r) { const float p = __builtin_amdgcn_exp2f(x[j][r] - m); x[j][r] = p; l += p; }
        l += __shfl_xor(l, 32);
        ATT_STORE(pre, Vl);
        const AttnU Uc = U; const int un = u + stride; const bool more = un < 3072;
        if (more) { U = attn_decode(P, un); ATT_LOAD(pre, U, PC_K); ATT_LOADQ(U); }
        LDS_BAR();
        f32x16 o[2];
#pragma unroll
        for (int r = 0; r < 16; ++r) { o[0][r] = 0.f; o[1][r] = 0.f; }
#pragma unroll
        for (int j = 0; j < 5; ++j)
#pragma unroll
            for (int s = 0; s < 2; ++s) { const bf16x8 pa = pack8(x[j], 8 * s);
#pragma unroll
                for (int c = 0; c < 2; ++c) o[c] = __builtin_amdgcn_mfma_f32_32x32x16_bf16(pa, tr_frag_acc(Vl, ATT_PITCH, 32 * w + 32 * j + 16 * s, 32 * c, lane), o[c], 0, 0, 0); }
        const float lse2 = m + __log2f(l);
        const size_t ob = Uc.orow0 + (size_t)Uc.d * (Uc.l0 + 32 * w);
#pragma unroll
        for (int rr = 0; rr < 16; ++rr) { const int qq = crow(rr, hi); const float inv = 1.0f / __shfl(l, qq); bf16* dst = OG + (ob + (size_t)Uc.d * qq) * 512 + Uc.h * 64 + q;
            dst[0] = (bf16)(cvtpk(o[0][rr] * inv, 0.f) & 0xffffu); dst[32] = (bf16)(cvtpk(o[1][rr] * inv, 0.f) & 0xffffu); }
        if (hi == 0) LSE[(ob + (size_t)Uc.d * q) * 8 + Uc.h] = lse2;
        if (!more) break;
        u = un;
    }
    LDS_BAR();
#undef ATT_LOAD
#undef ATT_STORE
#undef ATT_LOADQ
}

constexpr int GKP = 144, GVP = 320;
__device__ __forceinline__ void gla_gates2(const Args& a, const LAS float* glrL, int h, int wave, int lane, LAS float* tot, float (&b)[8], float& blast) {
    float wa[16];
#pragma unroll
    for (int r = 0; r < 16; ++r) wa[r] = a.wa2[r * 256 + h * 64 + lane];
    const float bias = a.ba[h * 64 + lane];
    float run = 0.f;
#pragma unroll
    for (int i = 0; i < 8; ++i) { const LAS f32x4* gp4 = (const LAS f32x4*)(glrL + (8 * wave + i) * 16); float gp = bias;
#pragma unroll
        for (int r4 = 0; r4 < 4; ++r4) { const f32x4 gv = gp4[r4]; gp += gv[0] * wa[4 * r4] + gv[1] * wa[4 * r4 + 1] + gv[2] * wa[4 * r4 + 2] + gv[3] * wa[4 * r4 + 3]; }
        run += logsigf_(gp) * (1.0f / 16.0f); b[i] = run; }
    tot[wave * 64 + lane] = run;
    LDS_BAR();
    float pre = 0.f, all = 0.f;
#pragma unroll
    for (int s = 0; s < 8; ++s) { const float tv = tot[s * 64 + lane]; all += tv; pre += (s < wave) ? tv : 0.f; }
#pragma unroll
    for (int i = 0; i < 8; ++i) b[i] += pre;
    blast = all;
}
__device__ __forceinline__ void gla_g1_phase(Frame& F, const Args& a, unsigned char* ws, int first, int stride) {
    const bf16* P = (const bf16*)(ws + WS_P); const float* GLR = (const float*)(ws + WS_GLR); float* UT = (float*)(ws + WS_UT); float* DC = (float*)(ws + WS_DC);
    LAS unsigned char* gkL = F.lds + 0;
    LAS unsigned char* gvL = F.lds + 9216;
    LAS float* glrL = (LAS float*)(F.lds + 29696);
    LAS float* tot = (LAS float*)(F.lds + 33792);
    const int lane = F.lane, w = F.wave, tid = F.tid;
    int chunk = first; if (chunk >= NCHUNK) return;
    v4u rk, rv0, rv1; f32x4 rg = {0.f, 0.f, 0.f, 0.f};
#define G1_LOAD(CH) do { const int bh_ = (CH) >> 7, c_ = (CH) & 127, b_ = bh_ >> 2, h_ = bh_ & 3; const size_t row0_ = (size_t)b_ * SEQ + c_ * 64; \
        rk = *(const v4u*)(P + (row0_ + (tid >> 3)) * NPROJ + PC_GK + h_ * 64 + (tid & 7) * 8); \
        rv0 = *(const v4u*)(P + (row0_ + (tid >> 4)) * NPROJ + PC_GV + h_ * 128 + (tid & 15) * 8); rv1 = *(const v4u*)(P + (row0_ + 32 + (tid >> 4)) * NPROJ + PC_GV + h_ * 128 + (tid & 15) * 8); \
        if (tid < 256) rg = *(const f32x4*)(GLR + (row0_ + (tid >> 2)) * 16 + (tid & 3) * 4); } while (0)
    G1_LOAD(chunk);
    while (true) {
        const int h = (chunk >> 7) & 3;
        *(LAS v4u*)(gkL + (tid >> 3) * GKP + (tid & 7) * 16) = rk;
        *(LAS v4u*)(gvL + (tid >> 4) * GVP + (tid & 15) * 16) = rv0; *(LAS v4u*)(gvL + (32 + (tid >> 4)) * GVP + (tid & 15) * 16) = rv1;
        if (tid < 256) *(LAS f32x4*)(glrL + (tid >> 2) * 16 + (tid & 3) * 4) = rg;
        const int nchunk = chunk + stride; const bool more = nchunk < NCHUNK;
        if (more) G1_LOAD(nchunk);
        LDS_BAR();
        float bb[8], blast;
        gla_gates2(a, glrL, h, w, lane, tot, bb, blast);
#pragma unroll
        for (int i = 0; i < 8; ++i) { LAS bf16* pk = (LAS bf16*)(gkL + (8 * w + i) * GKP) + lane; const float kd = bf2f(*pk) * __expf(blast - bb[i]); *pk = (bf16)(cvtpk(kd, 0.f) & 0xffffu); }
        if (w == 0) DC[(size_t)chunk * 64 + lane] = __expf(blast);
        LDS_BAR();
        const int vt = w >> 1, kt = w & 1, hi = lane >> 5;
        f32x16 acc;
#pragma unroll
        for (int r = 0; r < 16; ++r) acc[r] = 0.f;
#pragma unroll
        for (int s = 0; s < 4; ++s) acc = __builtin_amdgcn_mfma_f32_32x32x16_bf16(tr_frag(gvL, GVP, 16 * s, 32 * vt, lane), tr_frag(gkL, GKP, 16 * s, 32 * kt, lane), acc, 0, 0, 0);
        float* ut = UT + (size_t)chunk * 8192;
#pragma unroll
        for (int r = 0; r < 16; ++r) ut[(32 * vt + crow(r, hi)) * 64 + 32 * kt + (lane & 31)] = acc[r];
        LDS_BAR();
        if (!more) break;
        chunk = nchunk;
    }
#undef G1_LOAD
}
__device__ __forceinline__ void gla_g3_phase(Frame& F, const Args& a, unsigned char* ws, int first, int stride) {
    const bf16* P = (const bf16*)(ws + WS_P); const float* GLR = (const float*)(ws + WS_GLR); const bf16* ST = (const bf16*)(ws + WS_ST); bf16* A2 = (bf16*)(ws + WS_A2);
    LAS unsigned char* gqL = F.lds + 0;
    LAS unsigned char* gkL = F.lds + 9216;
    LAS unsigned char* gvL = F.lds + 18432;
    LAS unsigned char* sTL = F.lds + 38912;
    LAS float* glrL = (LAS float*)(F.lds + 57344);
    LAS float* tot = (LAS float*)(F.lds + 61440);
    LAS float* oL = (LAS float*)(F.lds + 63488);
    const int lane = F.lane, w = F.wave, tid = F.tid, hi = lane >> 5;
    int chunk = first; if (chunk >= NCHUNK) return;
    v4u rq, rk, rv0, rv1, rs0, rs1; f32x4 rg = {0.f, 0.f, 0.f, 0.f};
#define G3_LOAD(CH) do { const int bh_ = (CH) >> 7, c_ = (CH) & 127, b_ = bh_ >> 2, h_ = bh_ & 3; const size_t row0_ = (size_t)b_ * SEQ + c_ * 64; \
        rq = *(const v4u*)(P + (row0_ + (tid >> 3)) * NPROJ + PC_GQ + h_ * 64 + (tid & 7) * 8); rk = *(const v4u*)(P + (row0_ + (tid >> 3)) * NPROJ + PC_GK + h_ * 64 + (tid & 7) * 8); \
        rv0 = *(const v4u*)(P + (row0_ + (tid >> 4)) * NPROJ + PC_GV + h_ * 128 + (tid & 15) * 8); rv1 = *(const v4u*)(P + (row0_ + 32 + (tid >> 4)) * NPROJ + PC_GV + h_ * 128 + (tid & 15) * 8); \
        rs0 = *(const v4u*)(ST + (size_t)(CH) * 8192 + (tid >> 3) * 64 + (tid & 7) * 8); rs1 = *(const v4u*)(ST + (size_t)(CH) * 8192 + (64 + (tid >> 3)) * 64 + (tid & 7) * 8); \
        if (tid < 256) rg = *(const f32x4*)(GLR + (row0_ + (tid >> 2)) * 16 + (tid & 3) * 4); } while (0)
    G3_LOAD(chunk);
    while (true) {
        const int bh = chunk >> 7, c = chunk & 127, b = bh >> 2, h = bh & 3; const size_t row0 = (size_t)b * SEQ + c * 64;
        *(LAS v4u*)(gqL + (tid >> 3) * GKP + (tid & 7) * 16) = rq; *(LAS v4u*)(gkL + (tid >> 3) * GKP + (tid & 7) * 16) = rk;
        *(LAS v4u*)(gvL + (tid >> 4) * GVP + (tid & 15) * 16) = rv0; *(LAS v4u*)(gvL + (32 + (tid >> 4)) * GVP + (tid & 15) * 16) = rv1;
        *(LAS v4u*)(sTL + (tid >> 3) * GKP + (tid & 7) * 16) = rs0; *(LAS v4u*)(sTL + (64 + (tid >> 3)) * GKP + (tid & 7) * 16) = rs1;
        if (tid < 256) *(LAS f32x4*)(glrL + (tid >> 2) * 16 + (tid & 3) * 4) = rg;
        const int nchunk = chunk + stride; const bool more = nchunk < NCHUNK;
        if (more) G3_LOAD(nchunk);
        const bf16* gzp = P + (row0 + (tid >> 3)) * NPROJ + PC_GZ + h * 128 + 16 * (tid & 7); const v4u g0 = *(const v4u*)gzp, g1 = *(const v4u*)(gzp + 8);
        LDS_BAR();
        float bb[8], blast;
        gla_gates2(a, glrL, h, w, lane, tot, bb, blast);
#pragma unroll
        for (int i = 0; i < 8; ++i) { LAS bf16* pq = (LAS bf16*)(gqL + (8 * w + i) * GKP) + lane; LAS bf16* pk = (LAS bf16*)(gkL + (8 * w + i) * GKP) + lane;
            const float qv = bf2f(*pq) * 0.125f * __expf(bb[i]), kv = bf2f(*pk) * __expf(-bb[i]); *pq = (bf16)(cvtpk(qv, 0.f) & 0xffffu); *pk = (bf16)(cvtpk(kv, 0.f) & 0xffffu); }
        LDS_BAR();
        const int tt = w >> 2, vt = w & 3, x31 = lane & 31;
        f32x16 oacc;
#pragma unroll
        for (int r = 0; r < 16; ++r) oacc[r] = 0.f;
        bf16x8 qfr[4];
#pragma unroll
        for (int s = 0; s < 4; ++s) qfr[s] = *(const LAS bf16x8*)(gqL + (32 * tt + x31) * GKP + (16 * s + 8 * hi) * 2);
#pragma unroll
        for (int s = 0; s < 4; ++s) oacc = __builtin_amdgcn_mfma_f32_32x32x16_bf16(qfr[s], *(const LAS bf16x8*)(sTL + (32 * vt + x31) * GKP + (16 * s + 8 * hi) * 2), oacc, 0, 0, 0);
#pragma unroll
        for (int st = 0; st < 2; ++st) {
            if (st <= tt) {
                f32x16 xt;
#pragma unroll
                for (int r = 0; r < 16; ++r) xt[r] = 0.f;
#pragma unroll
                for (int s = 0; s < 4; ++s) xt = __builtin_amdgcn_mfma_f32_32x32x16_bf16(*(const LAS bf16x8*)(gkL + (32 * st + x31) * GKP + (16 * s + 8 * hi) * 2), qfr[s], xt, 0, 0, 0);
#pragma unroll
                for (int r = 0; r < 16; ++r) { const int sx = 32 * st + crow(r, hi), t = 32 * tt + x31; xt[r] = (sx <= t) ? xt[r] : 0.f; }
#pragma unroll
                for (int s2 = 0; s2 < 2; ++s2) oacc = __builtin_amdgcn_mfma_f32_32x32x16_bf16(pack8(xt, 8 * s2), tr_frag_acc(gvL, GVP, 32 * st + 16 * s2, 32 * vt, lane), oacc, 0, 0, 0);
            }
        }
#pragma unroll
        for (int r = 0; r < 16; ++r) oL[(32 * tt + crow(r, hi)) * 132 + 32 * vt + x31] = oacc[r];
        LDS_BAR();
        { const int t = tid >> 3, v8 = tid & 7;
          float ov[16]; float ss = 0.f;
#pragma unroll
          for (int i = 0; i < 4; ++i) { const f32x4 x = *(const LAS f32x4*)(oL + t * 132 + 16 * v8 + 4 * i); ov[4 * i] = x[0]; ov[4 * i + 1] = x[1]; ov[4 * i + 2] = x[2]; ov[4 * i + 3] = x[3]; ss += (x[0] * x[0] + x[1] * x[1]) + (x[2] * x[2] + x[3] * x[3]); }
          ss += __shfl_xor(ss, 1); ss += __shfl_xor(ss, 2); ss += __shfl_xor(ss, 4);
          const float rstd = 1.0f / sqrtf(ss * (1.0f / 128.0f) + NORM_EPS);
          const float* nw = a.gnw + 16 * v8;
          const unsigned gzw[8] = {g0.x, g0.y, g0.z, g0.w, g1.x, g1.y, g1.z, g1.w}; unsigned ow[8];
#pragma unroll
          for (int i = 0; i < 8; ++i) { const float y0 = ov[2 * i] * rstd * nw[2 * i] * siluf_(bflo(gzw[i])), y1 = ov[2 * i + 1] * rstd * nw[2 * i + 1] * siluf_(bfhi(gzw[i])); ow[i] = cvtpk(y0, y1); }
          bf16* dst = A2 + (row0 + t) * 512 + h * 128 + 16 * v8; *(v4u*)dst = (v4u){ow[0], ow[1], ow[2], ow[3]}; *(v4u*)(dst + 8) = (v4u){ow[4], ow[5], ow[6], ow[7]}; }
        if (!more) break;
        chunk = nchunk;
    }
    LDS_BAR();
#undef G3_LOAD
}


typedef float f32x4v __attribute__((ext_vector_type(4)));
__device__ __forceinline__ void glr_tiles(Frame& F, unsigned char* ws, int gw, int ngw) {
    const bf16* XN = (const bf16*)(ws + WS_XN); const bf16* Wg = (const bf16*)(ws + WS_WIN) + (size_t)8704 * 1024; float* GLR = (float*)(ws + WS_GLR);
    const int lane = F.lane, r16 = lane & 15, kg = lane >> 4;
    for (int tile = gw; tile < MT / 16; tile += ngw) {
        const bf16* ap = XN + (size_t)(tile * 16 + r16) * 1024 + 8 * kg; const bf16* bp = Wg + (size_t)r16 * 1024 + 8 * kg;
        f32x4v acc = {0.f, 0.f, 0.f, 0.f};
#pragma unroll 8
        for (int s2 = 0; s2 < 32; ++s2) acc = __builtin_amdgcn_mfma_f32_16x16x32_bf16(*(const bf16x8*)(ap + 32 * s2), *(const bf16x8*)(bp + 32 * s2), acc, 0, 0, 0);
#pragma unroll
        for (int i = 0; i < 4; ++i) GLR[(size_t)(tile * 16 + 4 * kg + i) * 16 + r16] = acc[i];
    }
}
__device__ __forceinline__ f32x16 small_acc(const bf16* A, int lda, const bf16* Bt, int ldb, int row, int col, int k0, int nsteps, int hi) {
    f32x16 acc;
#pragma unroll
    for (int r = 0; r < 16; ++r) acc[r] = 0.f;
    const bf16* ap = A + (size_t)row * lda + k0 + 8 * hi; const bf16* bp = Bt + (size_t)col * ldb + k0 + 8 * hi;
#pragma unroll 8
    for (int s2 = 0; s2 < nsteps; ++s2) acc = __builtin_amdgcn_mfma_f32_32x32x16_bf16(*(const bf16x8*)(ap + 16 * s2), *(const bf16x8*)(bp + 16 * s2), acc, 0, 0, 0);
    return acc;
}
__device__ __forceinline__ void sample_merge_tiles(Frame& F, unsigned char* ws) {
    const bf16* P = (const bf16*)(ws + WS_P); const bf16* A1 = (const bf16*)(ws + WS_A1); const bf16* A2 = (const bf16*)(ws + WS_A2); bf16* MIX = (bf16*)(ws + WS_MIX);
    const bf16* Wa = (const bf16*)(ws + WS_WA); const bf16* Wb = (const bf16*)(ws + WS_WB);
    LAS float* xch = (LAS float*)(F.lds);
    const int lane = F.lane, w = F.wave, hi = lane >> 5, x31 = lane & 31, mt = w & 1, nt = (w >> 1) & 1, kh = w >> 2;
    for (int tile = F.bid; tile < 256; tile += F.G) {
        const int rt = tile >> 4, ct = tile & 15;
        const int row = MP + 64 * rt + 32 * mt + x31, col = 64 * ct + 32 * nt + x31;
        f32x16 ya = small_acc(A1, 512, Wa, 512, row, col, 256 * kh, 16, hi);
        f32x16 yb = small_acc(A2, 512, Wb, 512, row, col, 256 * kh, 16, hi);
        if (kh == 1) {
#pragma unroll
            for (int r = 0; r < 16; ++r) { xch[((w - 4) * 32 + r) * 64 + lane] = ya[r]; xch[((w - 4) * 32 + 16 + r) * 64 + lane] = yb[r]; } }
        LDS_BAR();
        if (kh == 0) {
#pragma unroll
            for (int r = 0; r < 16; ++r) { ya[r] += xch[(w * 32 + r) * 64 + lane]; yb[r] += xch[(w * 32 + 16 + r) * 64 + lane]; }
#pragma unroll
            for (int r = 0; r < 16; ++r) { const size_t orow = (size_t)MP + 64 * rt + 32 * mt + crow(r, hi);
                const float sa = sigmoidf_(bf2f(P[orow * NPROJ + PC_MGA + col])), sb = sigmoidf_(bf2f(P[orow * NPROJ + PC_MGB + col]));
                MIX[orow * 1024 + col] = (bf16)(cvtpk(sa * ya[r] + sb * yb[r], 0.f) & 0xffffu); }
        }
        LDS_BAR();
    }
}
__device__ __forceinline__ void sample_out_tiles(Frame& F, const Args& a, unsigned char* ws, float* outp) {
    const bf16* MIX = (const bf16*)(ws + WS_MIX); const bf16* Wo = (const bf16*)(ws + WS_WO); float* rowss = (float*)(ws + WS_ROWSS);
    LAS float* xch = (LAS float*)(F.lds);
    LAS float* tl = (LAS float*)(F.lds + 16384);
    const int lane = F.lane, w = F.wave, hi = lane >> 5, x31 = lane & 31, mt = w & 1, nt = (w >> 1) & 1, kh = w >> 2;
    for (int tile = F.bid; tile < 256; tile += F.G) {
        const int rt = tile >> 4, ct = tile & 15;
        const int row = MP + 64 * rt + 32 * mt + x31, col = 64 * ct + 32 * nt + x31;
        f32x16 acc = small_acc(MIX, 1024, Wo, 1024, row, col, 512 * kh, 32, hi);
        if (kh == 1) {
#pragma unroll
            for (int r = 0; r < 16; ++r) xch[((w - 4) * 16 + r) * 64 + lane] = acc[r]; }
        LDS_BAR();
        if (kh == 0) {
#pragma unroll
            for (int r = 0; r < 16; ++r) { const int lr = 32 * mt + crow(r, hi); const size_t srow = (size_t)64 * rt + lr;
                const float pre = a.xs[srow * 1024 + col] + acc[r] + xch[(w * 16 + r) * 64 + lane];
                outp[OFF_Y + ((size_t)MP + srow) * 1024 + col] = pre; tl[lr * 65 + 32 * nt + x31] = pre; }
        }
        LDS_BAR();
        if (F.tid < 64) { float ss = 0.f;
#pragma unroll 8
            for (int c2 = 0; c2 < 64; ++c2) { const float v = tl[F.tid * 65 + c2]; ss += v * v; }
            rowss[((size_t)MP + 64 * rt + F.tid) * 16 + ct] = ss; }
        LDS_BAR();
    }
}

__global__ void __launch_bounds__(NWAVES * 64, 2) hybrid_fwd(Args args) {
    extern __shared__ __attribute__((aligned(16))) unsigned char lds[];
    gu32* ctl0 = (gu32*)(args.ws + WS_CTL);
    const int wave0 = __builtin_amdgcn_readfirstlane((int)threadIdx.x >> 6);
    for (int u = threadIdx.x; u < (LDS_BYTES - LDSCTL_OFF) / 4; u += NWAVES * 64) ((LAS unsigned*)((LAS unsigned char*)lds + LDSCTL_OFF))[u] = 0u;
    __syncthreads();
    XcdBarrier bar = xcd_barrier_post((unsigned*)(ctl0 + CW_BAR), (volatile LAS unsigned*)((LAS unsigned char*)lds + MISC_OFF) + 8);
#define FRESH(A) const Args& A = args; size_t z_ = 0; asm volatile("" : "+s"(z_)); unsigned char* ws = args.ws + z_; float* outp = args.out + z_; (void)A; \
    Frame F; { int l_; asm volatile("v_mbcnt_lo_u32_b32 %0, -1, 0\n\tv_mbcnt_hi_u32_b32 %0, -1, %0" : "=v"(l_)); int t_ = wave0 * 64 + l_; F.lds = (LAS unsigned char*)lds; F.MISC = (volatile LAS unsigned*)(F.lds + MISC_OFF); F.tid = t_; F.lane = t_ & 63; \
      F.wave = wave0; F.G = gridDim.x; F.bid = blockIdx.x; F.ctl = (gu32*)(ws + WS_CTL); }

#ifndef SKIP_P0
    { FRESH(A); p0_prologue(F, A, ws, outp); }
#endif
    xcd_barrier(bar);

#ifndef SKIP_P1
    { FRESH(A); pg8::Gemm g{(const pg8::bf16_t*)(ws + WS_XN), (const pg8::bf16_t*)(ws + WS_WIN), MT, NPROJ, DM}; pg8::StaticOrder S; S.init(MT, NPROJ, F.G, F.bid);
      EpiProj E{(bf16*)(ws + WS_P), (float*)(ws + WS_GLR), (const float*)(ws + WS_ROPE), (const float*)(ws + WS_ROPE) + 8200 * 8, outp};
      pg8::gemm_phase<EpiProj, pg8::StaticOrder, true, true>(F.lds + RING_OFF, g, S, E, F.tid); }
    { FRESH(A);
      const int nfull = (MT / 256) * (NPROJ / 256) % F.G; const int nidle = F.G - nfull;
      if (nfull == 0) glr_tiles(F, ws, F.bid * NWAVES + F.wave, F.G * NWAVES); else if (F.bid >= nfull) glr_tiles(F, ws, (F.bid - nfull) * NWAVES + F.wave, nidle * NWAVES); }
#endif
    xcd_barrier(bar);

#ifndef SKIP_P2A
    { FRESH(A); attn_prompt_phase(F, ws, F.bid, F.G); }
#endif
#ifndef SKIP_P2B
    { FRESH(A); for (int u = F.bid; u < 1664; u += F.G) attn_sample_unit(F, A, u, ws, outp); }
#endif
#ifndef SKIP_P2C
    { FRESH(A); gla_g1_phase(F, A, ws, F.bid, F.G); }
#endif
#ifndef SKIP_P2D
    { FRESH(A); for (int u = F.bid; u < 512; u += F.G) gla_sample_unit(F, A, u, ws, outp); }
#endif
    xcd_barrier(bar);

#ifndef SKIP_P3
    { FRESH(A); gla_scan(F, A, ws, outp); }
#endif
    xcd_barrier(bar);

#ifndef SKIP_P4
    { FRESH(A); gla_g3_phase(F, A, ws, F.bid, F.G); }
    { FRESH(A); combine_rows(F, A, ws, outp); }
#endif
    xcd_barrier(bar);

#ifndef SKIP_P5
    { FRESH(A); pg8::Gemm g{(const pg8::bf16_t*)(ws + WS_A1), (const pg8::bf16_t*)(ws + WS_WA), MP, DM, 512}; pg8::StaticOrder S; S.init(MP, DM, F.G, F.bid);
      EpiGateA E{(const bf16*)(ws + WS_P), (bf16*)(ws + WS_MIX)};
      pg8::gemm_phase<EpiGateA, pg8::StaticOrder, true, true>(F.lds + RING_OFF, g, S, E, F.tid); }
    { FRESH(A); pg8::Gemm g{(const pg8::bf16_t*)(ws + WS_A2), (const pg8::bf16_t*)(ws + WS_WB), MP, DM, 512}; pg8::StaticOrder S; S.init(MP, DM, F.G, F.bid);
      EpiGateB E{(const bf16*)(ws + WS_P), (bf16*)(ws + WS_MIX)};
      pg8::gemm_phase<EpiGateB, pg8::StaticOrder, true, true>(F.lds + RING_OFF, g, S, E, F.tid); }
    { FRESH(A); sample_merge_tiles(F, ws); }
#endif
    xcd_barrier(bar);

#ifndef SKIP_P6
    { FRESH(A); pg8::Gemm g{(const pg8::bf16_t*)(ws + WS_MIX), (const pg8::bf16_t*)(ws + WS_WO), MP, DM, DM}; pg8::StaticOrder S; S.init(MP, DM, F.G, F.bid);
      EpiResid E{A.xp, A.xs, outp + OFF_Y, (float*)(ws + WS_ROWSS)};
      pg8::gemm_phase<EpiResid, pg8::StaticOrder, true, true>(F.lds + RING_OFF, g, S, E, F.tid); }
    { FRESH(A); sample_out_tiles(F, A, ws, outp); }
#endif
    xcd_barrier(bar);

#ifndef SKIP_P7
    { FRESH(A); final_norm(F, A, ws, outp); }
#endif
}

extern "C" void kernel_launch(void* const* d_in, const int* in_sizes, int n_in, void* d_out, int out_size, void* d_ws, size_t ws_size, hipStream_t stream) {
    static int grid = 0;
    if (grid == 0) {
        if (n_in != 15 || (size_t)out_size != OUT_TOTAL || ws_size < WS_END) { fprintf(stderr, "kernel_launch: unexpected sizes n_in %d out %d ws %zu\n", n_in, out_size, ws_size); grid = -1; return; }
        int dev = 0, cus = 0, per_cu = 0;
        if (hipGetDevice(&dev) != hipSuccess || hipDeviceGetAttribute(&cus, hipDeviceAttributeMultiprocessorCount, dev) != hipSuccess) { grid = -1; return; }
        if (hipFuncSetAttribute((const void*)hybrid_fwd, hipFuncAttributeMaxDynamicSharedMemorySize, LDS_BYTES) != hipSuccess) { fprintf(stderr, "kernel_launch: hipFuncSetAttribute failed\n"); grid = -1; return; }
        if (hipOccupancyMaxActiveBlocksPerMultiprocessor(&per_cu, (const void*)hybrid_fwd, NWAVES * 64, LDS_BYTES) != hipSuccess || per_cu < 1)
            fprintf(stderr, "kernel_launch: note: occupancy query reports %d workgroups per CU\n", per_cu);
        (void)hipGetLastError();
        grid = cus;
    }
    if (grid < 0) return;
    if (hipMemsetAsync((char*)d_ws + WS_CTL, 0, CTL_ZERO_BYTES, stream) != hipSuccess) return;
    Args a{};
    a.xp = (const float*)d_in[0]; a.xs = (const float*)d_in[1]; a.c128 = (const float*)d_in[2]; a.c512 = (const float*)d_in[3]; a.c2048 = (const float*)d_in[4]; a.sgla = (const float*)d_in[5];
    a.lnw = (const float*)d_in[6]; a.win = (const float*)d_in[7]; a.wa2 = (const float*)d_in[8]; a.ba = (const float*)d_in[9]; a.gnw = (const float*)d_in[10]; a.wao = (const float*)d_in[11];
    a.wgo = (const float*)d_in[12]; a.wout = (const float*)d_in[13]; a.fnw = (const float*)d_in[14];
    a.out = (float*)d_out; a.ws = (unsigned char*)d_ws;
    hipLaunchKernelGGL(hybrid_fwd, dim3(grid), dim3(NWAVES * 64), LDS_BYTES, stream, a);
}
```
